# Optimizing an MI355X kernel written in HIP

```python
import math
import jax, jax.numpy as jnp
from jax import lax
import numpy as np

D_MODEL = 4096
BATCH = 2
SEQ = 4096
DEPTH = 1
DEC_BATCH = 32
DEC_SEQ = 64
PAST_LEN = 1024

CHUNK = 64
D_MIX = D_MODEL
D_ATTN = D_MIX // 2
D_SSM = D_MIX - D_ATTN
HEAD_DIM = 128
N_HEADS = D_ATTN // HEAD_DIM
SSM_GROUP = 16
N_GROUPS = D_SSM // SSM_GROUP
SSM_STATE = 64
D_FF = 256 * ((8 * D_MODEL // 3 + 255) // 256)
N_IN = 3 * D_ATTN + N_HEADS + D_SSM
Q_BLOCK = 128
EPS = 1e-6
NEG_INF = -1e30
ATTN_SCALE = HEAD_DIM ** -0.5
FORGET_BIAS_MEAN = 2.0
DT_MIN = 0.001
DT_MAX = 0.1

kernel_name = 'hymba_fox_s5_macaron_stream_step'


def rms_norm(x, g):
    xf = x.astype(jnp.float32)
    y = xf * lax.rsqrt(jnp.mean(xf * xf, axis=-1, keepdims=True) + EPS)
    return (y * g.astype(jnp.float32)).astype(x.dtype)


def swiglu(h, w1, w3, w2):
    return (jax.nn.silu(h @ w1) * (h @ w3)) @ w2


def combined_projection(h, w_in, b_f, q_norm, k_norm):
    b, s, _ = h.shape
    z = h @ w_in
    q = rms_norm(z[..., :D_ATTN].reshape(b, s, N_HEADS, HEAD_DIM), q_norm)
    k = rms_norm(z[..., D_ATTN:2 * D_ATTN].reshape(b, s, N_HEADS, HEAD_DIM), k_norm)
    v = z[..., 2 * D_ATTN:3 * D_ATTN].reshape(b, s, N_HEADS, HEAD_DIM)
    logf = jax.nn.log_sigmoid((z[..., 3 * D_ATTN:3 * D_ATTN + N_HEADS] + b_f).astype(jnp.float32))
    u = z[..., 3 * D_ATTN + N_HEADS:].reshape(b, s, N_GROUPS, SSM_GROUP)
    return q, k, v, logf, u


def fox_attend(q, k, v, f_q, f_k, q_pos, k_pos):
    s = jnp.einsum('bqhd,bkhd->bhqk', q, k, preferred_element_type=jnp.float32) * ATTN_SCALE
    s = s + jnp.swapaxes(f_q, 1, 2)[:, :, :, None] - jnp.swapaxes(f_k, 1, 2)[:, :, None, :]
    s = jnp.where(k_pos[None, :] <= q_pos[:, None], s, NEG_INF)
    p = jax.nn.softmax(s, axis=-1)
    return jnp.einsum('bhqk,bkhd->bqhd', p.astype(v.dtype), v)


def fox_prompt(q, k, v, f):
    b, s = q.shape[:2]
    nb = s // Q_BLOCK
    qb = q.reshape(b, nb, Q_BLOCK, N_HEADS, HEAD_DIM).transpose(1, 0, 2, 3, 4)
    fb = f.reshape(b, nb, Q_BLOCK, N_HEADS).transpose(1, 0, 2, 3)
    k_pos = jnp.arange(s)

    def one_block(args):
        q_i, f_i, i = args
        q_pos = i * Q_BLOCK + jnp.arange(Q_BLOCK)
        return fox_attend(q_i, k, v, f_i, f, q_pos, k_pos)

    o = lax.map(one_block, (qb, fb, jnp.arange(nb)))
    return o.transpose(1, 0, 2, 3, 4).reshape(b, s, N_HEADS, HEAD_DIM)


def _ssm_combine(left, right):
    a_l, b_l = left
    a_r, b_r = right
    return a_l * a_r, a_r * b_l + b_r


def s5_mixer(u, x0, lam_re, lam_im, log_dt, b_re, b_im, c_re, c_im, d_skip, w_glu):
    bsz, s = u.shape[:2]
    f32 = jnp.float32
    lam = lax.complex(lam_re.astype(f32), lam_im.astype(f32))
    dt = jnp.exp(log_dt.astype(f32))[:, None]
    lam_bar = jnp.exp(lam * dt)
    b_bar = ((lam_bar - 1.0) / lam)[:, :, None] * lax.complex(b_re.astype(f32), b_im.astype(f32))
    c = lax.complex(c_re.astype(f32), c_im.astype(f32))
    uf = u.astype(f32)
    bu = jnp.einsum('gpc,bsgc->bsgp', b_bar, uf.astype(jnp.complex64))
    a = jnp.broadcast_to(lam_bar, (1, s) + lam_bar.shape)
    a_cum, xs = lax.associative_scan(_ssm_combine, (a, bu), axis=1)
    if x0 is not None:
        xs = xs + a_cum * x0[:, None]
    y = jnp.real(jnp.einsum('gcp,bsgp->bsgc', c, xs)) + d_skip.astype(f32).reshape(N_GROUPS, SSM_GROUP) * uf
    y = jax.nn.gelu(y.reshape(bsz, s, D_SSM))
    y = y * jax.nn.sigmoid(y @ w_glu.astype(f32))
    return y.astype(u.dtype), xs[:, -1]


def merge_heads(o_attn, y_ssm, g_attn, g_ssm, w_out):
    return jnp.concatenate([rms_norm(o_attn, g_attn), rms_norm(y_ssm, g_ssm)], axis=-1) @ w_out


def setup_inputs(seed: int = 0) -> dict:
    key = jax.random.key(seed)
    ks = jax.random.split(key, 32)
    f32 = jnp.float32
    L = DEPTH

    def nrm(k, shape, scale):
        return jax.random.normal(k, shape, f32) * scale

    def gain(k, shape):
        return 1.0 + 0.01 * jax.random.normal(k, shape, f32)

    return {
        'x_prompt': nrm(ks[0], (BATCH, SEQ, D_MODEL), 1.0),
        'x_sample': nrm(ks[1], (DEC_BATCH, DEC_SEQ, D_MODEL), 1.0),
        'cache_k': nrm(ks[2], (L, DEC_BATCH, PAST_LEN, N_HEADS, HEAD_DIM), 1.0),
        'cache_v': nrm(ks[3], (L, DEC_BATCH, PAST_LEN, N_HEADS, HEAD_DIM), 1.0),
        'cache_logf': jax.nn.log_sigmoid(FORGET_BIAS_MEAN + jax.random.normal(ks[4], (L, DEC_BATCH, PAST_LEN, N_HEADS), f32)),
        'state_ssm_re': nrm(ks[5], (L, DEC_BATCH, N_GROUPS, SSM_STATE), 0.5),
        'state_ssm_im': nrm(ks[6], (L, DEC_BATCH, N_GROUPS, SSM_STATE), 0.5),
        'norm_ffn1': gain(ks[7], (L, D_MODEL)),
        'w1_a': nrm(ks[8], (L, D_MODEL, D_FF), D_MODEL ** -0.5),
        'w3_a': nrm(ks[9], (L, D_MODEL, D_FF), D_MODEL ** -0.5),
        'w2_a': nrm(ks[10], (L, D_FF, D_MODEL), D_FF ** -0.5),
        'norm_mix': gain(ks[11], (L, D_MODEL)),
        'w_in': nrm(ks[12], (L, D_MODEL, N_IN), D_MODEL ** -0.5),
        'b_f': FORGET_BIAS_MEAN + nrm(ks[13], (L, N_HEADS), 0.1),
        'q_norm': gain(ks[14], (L, HEAD_DIM)),
        'k_norm': gain(ks[15], (L, HEAD_DIM)),
        'lam_re': -0.5 + nrm(ks[16], (L, N_GROUPS, SSM_STATE), 0.01),
        'lam_im': math.pi * jnp.arange(SSM_STATE, dtype=f32) + nrm(ks[17], (L, N_GROUPS, SSM_STATE), 0.01),
        'log_dt': jax.random.uniform(ks[18], (L, N_GROUPS), f32, math.log(DT_MIN), math.log(DT_MAX)),
        'b_re': nrm(ks[19], (L, N_GROUPS, SSM_STATE, SSM_GROUP), (2 * SSM_GROUP) ** -0.5),
        'b_im': nrm(ks[20], (L, N_GROUPS, SSM_STATE, SSM_GROUP), (2 * SSM_GROUP) ** -0.5),
        'c_re': nrm(ks[21], (L, N_GROUPS, SSM_GROUP, SSM_STATE), (2 * SSM_STATE) ** -0.5),
        'c_im': nrm(ks[22], (L, N_GROUPS, SSM_GROUP, SSM_STATE), (2 * SSM_STATE) ** -0.5),
        'd_skip': nrm(ks[23], (L, D_SSM), 1.0),
        'w_glu': nrm(ks[24], (L, D_SSM, D_SSM), D_SSM ** -0.5),
        'out_norm_attn': gain(ks[25], (L, D_ATTN)),
        'out_norm_ssm': gain(ks[26], (L, D_SSM)),
        'w_out': nrm(ks[27], (L, D_MIX, D_MODEL), D_MIX ** -0.5),
        'norm_ffn2': gain(ks[28], (L, D_MODEL)),
        'w1_b': nrm(ks[29], (L, D_MODEL, D_FF), D_MODEL ** -0.5),
        'w3_b': nrm(ks[30], (L, D_MODEL, D_FF), D_MODEL ** -0.5),
        'w2_b': nrm(ks[31], (L, D_FF, D_MODEL), D_FF ** -0.5),
    }


def reference(x_prompt, x_sample, cache_k, cache_v, cache_logf, state_ssm_re, state_ssm_im,
              norm_ffn1, w1_a, w3_a, w2_a, norm_mix, w_in, b_f, q_norm, k_norm,
              lam_re, lam_im, log_dt, b_re, b_im, c_re, c_im, d_skip, w_glu,
              out_norm_attn, out_norm_ssm, w_out, norm_ffn2, w1_b, w3_b, w2_b):
    f32 = jnp.float32
    xp, xs = x_prompt, x_sample
    bp, s_len = xp.shape[:2]
    t_len = xs.shape[1]
    past = cache_k.shape[2]
    kp_l, vp_l, fp_l, srp_l, sip_l = [], [], [], [], []
    ks_l, vs_l, fs_l, srs_l, sis_l = [], [], [], [], []
    for l in range(DEPTH):
        ssm_w = (lam_re[l], lam_im[l], log_dt[l], b_re[l], b_im[l], c_re[l], c_im[l], d_skip[l], w_glu[l])
        xp = xp + 0.5 * swiglu(rms_norm(xp, norm_ffn1[l]), w1_a[l], w3_a[l], w2_a[l])
        xs = xs + 0.5 * swiglu(rms_norm(xs, norm_ffn1[l]), w1_a[l], w3_a[l], w2_a[l])

        q, k, v, logf, u = combined_projection(rms_norm(xp, norm_mix[l]), w_in[l], b_f[l], q_norm[l], k_norm[l])
        o = fox_prompt(q, k, v, jnp.cumsum(logf, axis=1))
        y, last = s5_mixer(u, None, *ssm_w)
        xp = xp + merge_heads(o.reshape(bp, s_len, D_ATTN), y, out_norm_attn[l], out_norm_ssm[l], w_out[l])
        kp_l.append(k)
        vp_l.append(v)
        fp_l.append(logf)
        srp_l.append(jnp.real(last))
        sip_l.append(jnp.imag(last))

        q, k, v, logf, u = combined_projection(rms_norm(xs, norm_mix[l]), w_in[l], b_f[l], q_norm[l], k_norm[l])
        k_all = jnp.concatenate([cache_k[l].astype(k.dtype), k], axis=1)
        v_all = jnp.concatenate([cache_v[l].astype(v.dtype), v], axis=1)
        f_all = jnp.cumsum(jnp.concatenate([cache_logf[l].astype(f32), logf], axis=1), axis=1)
        o = fox_attend(q, k_all, v_all, f_all[:, past:], f_all, past + jnp.arange(t_len), jnp.arange(past + t_len))
        x0 = lax.complex(state_ssm_re[l].astype(f32), state_ssm_im[l].astype(f32))
        y, last = s5_mixer(u, x0, *ssm_w)
        xs = xs + merge_heads(o.reshape(xs.shape[0], t_len, D_ATTN), y, out_norm_attn[l], out_norm_ssm[l], w_out[l])
        ks_l.append(k)
        vs_l.append(v)
        fs_l.append(logf)
        srs_l.append(jnp.real(last))
        sis_l.append(jnp.imag(last))

        xp = xp + 0.5 * swiglu(rms_norm(xp, norm_ffn2[l]), w1_b[l], w3_b[l], w2_b[l])
        xs = xs + 0.5 * swiglu(rms_norm(xs, norm_ffn2[l]), w1_b[l], w3_b[l], w2_b[l])

    k_prompt = jnp.stack(kp_l, 0)
    v_prompt = jnp.stack(vp_l, 0)
    logf_prompt = jnp.stack(fp_l, 0)
    ssm_re_prompt = jnp.stack(srp_l, 0)
    ssm_im_prompt = jnp.stack(sip_l, 0)
    k_sample = jnp.stack(ks_l, 0)
    v_sample = jnp.stack(vs_l, 0)
    logf_sample = jnp.stack(fs_l, 0)
    ssm_re_sample = jnp.stack(srs_l, 0)
    ssm_im_sample = jnp.stack(sis_l, 0)
    return (xp, xs, k_prompt, v_prompt, logf_prompt, ssm_re_prompt, ssm_im_prompt,
            k_sample, v_sample, logf_sample, ssm_re_sample, ssm_im_sample)
```

```cpp
#include <hip/hip_runtime.h>
#include <cstdio>
#include <cstdint>
namespace pg8 {
#define PG8_LAS __attribute__((address_space(3)))
typedef unsigned short bf16_t;
typedef short bf16x8 __attribute__((ext_vector_type(8)));
typedef float f32x4 __attribute__((ext_vector_type(4)));
typedef unsigned u32x4 __attribute__((ext_vector_type(4)));
constexpr int BM = 256, BK = 64, HALF = 128, HTB = HALF * BK * 2  , STAGE_BYTES = 8 * HTB, NXCD = 8;

__host__ __device__ __forceinline__ int lds_byte(int r, int c) { const int st = (r >> 4) * 2 + (c >> 5), rr = r & 15, cc = c & 31, ob = rr * 64 + cc * 2; return st * 1024 + (ob ^ (((ob >> 9) & 1) << 5)); }
__host__ __device__ __forceinline__ void stage_rc(int b, int& R, int& C) { const int st = b / 1024, sb = b % 1024, swz = sb ^ (((sb >> 9) & 1) << 5); R = (st >> 1) * 16 + swz / 64; C = (st & 1) * 32 + (swz % 64) / 2; }
__host__ __device__ __forceinline__ int perm32(int rho) { const int n = rho >> 4, i = rho & 15; return 8 * (i >> 2) + 4 * n + (i & 3); }

struct Unit { int pm, pn, kt0, nkt, part; };
struct Gemm { const bf16_t* A; const bf16_t* Bt; int M, N, K; };

struct StaticOrder {
    int nM, nN, nwg, G, c, nt, WGM;
    __host__ __device__ void init(int M, int N, int K, int G_, int c_) { nM = M / BM; nN = N / BM; nwg = nM * nN; G = G_; c = c_; nt = K / BK; WGM = (nM % NXCD == 0) ? nM / NXCD : 8; }
    __host__ __device__ __forceinline__ bool next(int i, Unit& u) const {
        const long L = (long)i * G + c; const bool ok = L < nwg;
        int wgid = ok ? (int)L : 0; { const int q = nwg / NXCD, r = nwg % NXCD, xcd = wgid % NXCD, off = wgid / NXCD; wgid = (xcd < r ? xcd * (q + 1) : r * (q + 1) + (xcd - r) * q) + off; }
        const int nig = WGM * nN, gid = wgid / nig, fm = gid * WGM, gsz = (nM - fm) < WGM ? (nM - fm) : WGM;
        u.pm = fm + ((wgid % nig) % gsz); u.pn = (wgid % nig) / gsz; u.kt0 = 0; u.nkt = nt; u.part = 0; return ok;
    }
    __device__ __forceinline__ void a_ready(const Unit&) const {}
    __device__ __forceinline__ void done(const Unit&) const {}
};
struct SameOrder { int n;
    __host__ __device__ __forceinline__ bool next(int i, Unit& u) const { u.pm = 0; u.pn = 0; u.kt0 = 0; u.nkt = 32; u.part = 0; return i < n; }
    __device__ __forceinline__ void a_ready(const Unit&) const {}
    __device__ __forceinline__ void done(const Unit&) const {}
};
struct SplitOrder {
    StaticOrder so; int nfull, pm0, nN, rem, nt, c;
    __host__ __device__ void init(int M, int Mfull, int N, int K, int G, int c_) { so.init(Mfull, N, K, G, c_); nfull = so.nwg / G; pm0 = Mfull / BM; nN = N / BM; rem = ((M - Mfull) / BM) * nN; nt = K / BK; c = c_; }
    __host__ __device__ __forceinline__ bool next(int i, Unit& u) const {
        const bool full = i < nfull, split = i == nfull && rem > 0;
        Unit a; const bool oka = so.next(full ? i : 0, a);
        const int remc = rem > 0 ? rem : 1, ns = so.G / remc, prows = remc / nN > 0 ? remc / nN : 1, nk = nt / ns;
        int j = c % remc, part = c / remc;
#if !defined(SPLIT_PLAIN)
        { const int cpx = nN * ns / NXCD; if (NXCD % ns == 0 && cpx * NXCD == nN * ns && prows * cpx * NXCD == so.G) { const int xcd = c % NXCD, m = c / NXCD; part = xcd % ns; j = ((xcd / ns) * cpx + m / prows) * prows + m % prows; } }
#endif
        u.pm = full ? a.pm : pm0 + j % prows; u.pn = full ? a.pn : j / prows; u.part = full ? 0 : part; u.nkt = full ? nt : nk; u.kt0 = full ? 0 : part * nk;
        return full ? oka : split;
    }
    __device__ __forceinline__ void a_ready(const Unit&) const {}
    __device__ __forceinline__ void done(const Unit&) const {}
};

__device__ __forceinline__ unsigned cvt_pk_bf16(float lo, float hi) { unsigned r; asm volatile("v_cvt_pk_bf16_f32 %0, %1, %2" : "=v"(r) : "v"(lo), "v"(hi)); return r; }
typedef float f32x2 __attribute__((ext_vector_type(2)));

typedef unsigned u32x2 __attribute__((ext_vector_type(2)));
__device__ __forceinline__ float fast_sigmoid(float x) { return __builtin_amdgcn_rcpf(1.0f + __builtin_amdgcn_exp2f(-1.4426950408889634f * x)); }
typedef float f32x2v __attribute__((ext_vector_type(2)));
__device__ __forceinline__ f32x2v swiglu2(f32x2v g, f32x2v u) { const f32x2v t = g * (f32x2v){-1.4426950408889634f, -1.4426950408889634f};
    const f32x2v d = (f32x2v){__builtin_amdgcn_exp2f(t.x), __builtin_amdgcn_exp2f(t.y)} + (f32x2v){1.0f, 1.0f};
    return (g * u) * (f32x2v){__builtin_amdgcn_rcpf(d.x), __builtin_amdgcn_rcpf(d.y)}; }
struct EpiSwiGLU {
    static constexpr bool PERM = true, AFTER_DRAIN = false;
    bf16_t* Hh; int ldh;
    __device__ __forceinline__ void operator()(const f32x4 (&acc)[2][2][4][2], const Unit& u, int wr, int wc, int fr, int fq) const {
        const int row0 = u.pm * BM + wr * 64 + fr, col0 = u.pn * HALF + wc * 32 + 8 * fq;
#pragma unroll
        for (int ai = 0; ai < 2; ++ai)
#pragma unroll
            for (int m = 0; m < 4; ++m) { bf16_t* rowp = Hh + (size_t)(row0 + ai * HALF + m * 16) * ldh + col0;
                const f32x4 g0 = acc[ai][0][m][0], g1 = acc[ai][0][m][1], u0 = acc[ai][1][m][0], u1 = acc[ai][1][m][1];
                const f32x2v p0 = swiglu2((f32x2v){g0[0], g0[1]}, (f32x2v){u0[0], u0[1]}), p1 = swiglu2((f32x2v){g0[2], g0[3]}, (f32x2v){u0[2], u0[3]}),
                             p2 = swiglu2((f32x2v){g1[0], g1[1]}, (f32x2v){u1[0], u1[1]}), p3 = swiglu2((f32x2v){g1[2], g1[3]}, (f32x2v){u1[2], u1[3]});
                u32x4 w; w.x = cvt_pk_bf16(p0.x, p0.y); w.y = cvt_pk_bf16(p1.x, p1.y); w.z = cvt_pk_bf16(p2.x, p2.y); w.w = cvt_pk_bf16(p3.x, p3.y);
                *(u32x4*)rowp = w; }
    }
};
struct EpiRes {
    static constexpr bool PERM = false, AFTER_DRAIN = false;
    const float* base; const float* base2; int pm_split; float* out; int ldc; float s; float* part_out;
    __device__ __forceinline__ void operator()(const f32x4 (&acc)[2][2][4][2], const Unit& u, int wr, int wc, int fr, int fq) const {
        const int row0 = u.pm * BM + wr * 64 + fr, col0 = u.pn * BM + wc * 32 + 4 * fq;
        if (u.part != 0) {
#pragma unroll
            for (int ai = 0; ai < 2; ++ai)
#pragma unroll
                for (int m = 0; m < 4; ++m) { float* rowp = part_out + (size_t)(row0 + ai * HALF + m * 16) * ldc + col0;
#pragma unroll
                    for (int bj = 0; bj < 2; ++bj)
#pragma unroll
                        for (int n = 0; n < 2; ++n) *(f32x4*)(rowp + bj * HALF + n * 16) = acc[ai][bj][m][n] * s; }
            return; }
        const float* bs = u.pm >= pm_split ? base2 : base;
#pragma unroll
        for (int ai = 0; ai < 2; ++ai) { f32x4 b[4][2][2];
#pragma unroll
            for (int m = 0; m < 4; ++m) { const size_t off = (size_t)(row0 + ai * HALF + m * 16) * ldc + col0;
#pragma unroll
                for (int bj = 0; bj < 2; ++bj)
#pragma unroll
                    for (int n = 0; n < 2; ++n) b[m][bj][n] = *(const f32x4*)(bs + off + bj * HALF + n * 16); }
            asm volatile("" ::: "memory");
#pragma unroll
            for (int m = 0; m < 4; ++m) { const size_t off = (size_t)(row0 + ai * HALF + m * 16) * ldc + col0;
#pragma unroll
                for (int bj = 0; bj < 2; ++bj)
#pragma unroll
                    for (int n = 0; n < 2; ++n) *(f32x4*)(out + off + bj * HALF + n * 16) = b[m][bj][n] + acc[ai][bj][m][n] * s; }
            asm volatile("" ::: "memory"); }
    }
};
struct EpiWin {
    static constexpr bool PERM = true, AFTER_DRAIN = false;
    bf16_t* qnb; float* kp; float* vp; float* uu; bf16_t* kbp; bf16_t* vbp; const float* gq; const float* gk; PG8_LAS float* tab; int pm_split;
    long dks, dvs;
    __device__ __forceinline__ void operator()(const f32x4 (&acc)[2][2][4][2], const Unit& u, int wr, int wc, int fr, int fq) const {
        const int seg = u.pn >> 3; const bool smp = u.pm >= pm_split;
        const int row0 = u.pm * BM + wr * 64 + fr, col0 = (u.pn & 7) * BM + wc * 32 + 8 * fq;
        if (seg >= 2) {
            float* dst = seg == 2 ? vp + (smp ? dvs : 0l) : uu;
#pragma unroll
            for (int ai = 0; ai < 2; ++ai)
#pragma unroll
                for (int m = 0; m < 4; ++m) { const int row = row0 + ai * HALF + m * 16; float* rowp = dst + (size_t)row * 2048 + col0;
#pragma unroll
                    for (int bj = 0; bj < 2; ++bj) { *(f32x4*)(rowp + bj * HALF) = acc[ai][bj][m][0]; *(f32x4*)(rowp + bj * HALF + 4) = acc[ai][bj][m][1]; }
                    if (seg == 2 && !smp) { bf16_t* bp = vbp + (size_t)row * 2048 + col0;
#pragma unroll
                        for (int bj = 0; bj < 2; ++bj) { const f32x4 a = acc[ai][bj][m][0], b = acc[ai][bj][m][1]; u32x4 w; w.x = cvt_pk_bf16(a[0], a[1]); w.y = cvt_pk_bf16(a[2], a[3]); w.z = cvt_pk_bf16(b[0], b[1]); w.w = cvt_pk_bf16(b[2], b[3]);
                            *(u32x4*)(bp + bj * HALF) = w; } } }
            return; }
        const int rl0 = wr * 64 + fr;
#pragma unroll
        for (int ai = 0; ai < 2; ++ai)
#pragma unroll
            for (int m = 0; m < 4; ++m)
#pragma unroll
                for (int bj = 0; bj < 2; ++bj) { const f32x4 a = acc[ai][bj][m][0], b = acc[ai][bj][m][1];
                    float ss = ((a[0] * a[0] + a[1] * a[1]) + (a[2] * a[2] + a[3] * a[3])) + ((b[0] * b[0] + b[1] * b[1]) + (b[2] * b[2] + b[3] * b[3]));
                    ss += __shfl_xor(ss, 16); ss += __shfl_xor(ss, 32);
                    if (fq == 0) tab[((rl0 + ai * HALF + m * 16) * 2 + bj) * 4 + wc] = ss; }
        asm volatile("s_waitcnt lgkmcnt(0)" ::: "memory"); __builtin_amdgcn_s_barrier(); asm volatile("" ::: "memory");
        const f32x4 g0q = *(const f32x4*)(gq + wc * 32 + 8 * fq), g1q = *(const f32x4*)(gq + wc * 32 + 8 * fq + 4), g0k = *(const f32x4*)(gk + wc * 32 + 8 * fq), g1k = *(const f32x4*)(gk + wc * 32 + 8 * fq + 4);
        const f32x4 g0 = seg == 0 ? g0q : g0k, g1 = seg == 0 ? g1q : g1k;
#pragma unroll
        for (int ai = 0; ai < 2; ++ai)
#pragma unroll
            for (int m = 0; m < 4; ++m) { const int row = row0 + ai * HALF + m * 16;
#pragma unroll
                for (int bj = 0; bj < 2; ++bj) { const f32x4 t = *(const PG8_LAS f32x4*)(tab + ((rl0 + ai * HALF + m * 16) * 2 + bj) * 4);
                    const float r = __builtin_amdgcn_rsqf(((t[0] + t[1]) + (t[2] + t[3])) * (1.0f / 128.0f) + 1e-6f);
                    const f32x4 o0 = acc[ai][bj][m][0] * r * g0, o1 = acc[ai][bj][m][1] * r * g1;
                    u32x4 w; w.x = cvt_pk_bf16(o0[0], o0[1]); w.y = cvt_pk_bf16(o0[2], o0[3]); w.z = cvt_pk_bf16(o1[0], o1[1]); w.w = cvt_pk_bf16(o1[2], o1[3]);
                    if (seg == 0) { *(u32x4*)(qnb + (size_t)row * 2048 + col0 + bj * HALF) = w; }
                    else { float* kf = kp + (smp ? dks : 0l) + (size_t)row * 2048 + col0 + bj * HALF; *(f32x4*)kf = o0; *(f32x4*)(kf + 4) = o1;
                           if (!smp) *(u32x4*)(kbp + (size_t)row * 2048 + col0 + bj * HALF) = w; } } }
    }
};
struct EpiNull {
    static constexpr bool PERM = false, AFTER_DRAIN = false;
    __device__ __forceinline__ void operator()(const f32x4 (&acc)[2][2][4][2], const Unit& u, int wr, int wc, int fr, int fq) const {
#pragma unroll
        for (int ai = 0; ai < 2; ++ai)
#pragma unroll
            for (int bj = 0; bj < 2; ++bj)
#pragma unroll
                for (int m = 0; m < 4; ++m)
#pragma unroll
                    for (int n = 0; n < 2; ++n) asm volatile("" :: "v"(acc[ai][bj][m][n]));
    }
};
struct EpiGLU {
    static constexpr bool PERM = true, AFTER_DRAIN = false;
    const bf16_t* Y; bf16_t* O; int ldc;
    __device__ __forceinline__ void operator()(const f32x4 (&acc)[2][2][4][2], const Unit& u, int wr, int wc, int fr, int fq) const {
        const int row0 = u.pm * BM + wr * 64 + fr, col0 = u.pn * BM + wc * 32 + 8 * fq;
#pragma unroll
        for (int ai = 0; ai < 2; ++ai) { u32x4 yb[4][2];
#pragma unroll
            for (int m = 0; m < 4; ++m)
#pragma unroll
                for (int bj = 0; bj < 2; ++bj) yb[m][bj] = *(const u32x4*)(Y + (size_t)(row0 + ai * HALF + m * 16) * ldc + col0 + bj * HALF);
            asm volatile("" ::: "memory");
#pragma unroll
            for (int m = 0; m < 4; ++m) { const size_t off = (size_t)(row0 + ai * HALF + m * 16) * ldc + col0;
#pragma unroll
                for (int bj = 0; bj < 2; ++bj) { const u32x4 yv = yb[m][bj]; const f32x4 a0 = acc[ai][bj][m][0], a1 = acc[ai][bj][m][1];
                    float y[8]; y[0] = __uint_as_float(yv.x << 16); y[1] = __uint_as_float(yv.x & 0xffff0000u); y[2] = __uint_as_float(yv.y << 16); y[3] = __uint_as_float(yv.y & 0xffff0000u);
                    y[4] = __uint_as_float(yv.z << 16); y[5] = __uint_as_float(yv.z & 0xffff0000u); y[6] = __uint_as_float(yv.w << 16); y[7] = __uint_as_float(yv.w & 0xffff0000u);
                    float o[8];
#pragma unroll
                    for (int j = 0; j < 4; ++j) { o[j] = y[j] * fast_sigmoid(a0[j]); o[4 + j] = y[4 + j] * fast_sigmoid(a1[j]); }
                    u32x4 w; w.x = cvt_pk_bf16(o[0], o[1]); w.y = cvt_pk_bf16(o[2], o[3]); w.z = cvt_pk_bf16(o[4], o[5]); w.w = cvt_pk_bf16(o[6], o[7]);
                    *(u32x4*)(O + off + bj * HALF) = w; } } }
    }
};

template <class Epi, class Sched, bool ALIGN_EPI = false, bool SP2 = false>
__device__ __forceinline__ void gemm_phase(PG8_LAS unsigned char* lds, const Gemm g, const Sched& S, const Epi& E) {
    const int tid = threadIdx.x, wid = __builtin_amdgcn_readfirstlane(tid >> 6), lane = tid & 63, wr = wid >> 2, wc = wid & 3, fr = lane & 15, fq = lane >> 4;
    const int K = g.K;
    unsigned voffA[2], voffB[2];
#pragma unroll
    for (int i = 0; i < 2; ++i) { int R, C; stage_rc(tid * 16 + i * 8192, R, C); const int Rb = Epi::PERM ? ((R & ~31) + perm32(R & 31)) : R;
        voffA[i] = (unsigned)(R * K + C) * 2u; voffB[i] = (unsigned)(Rb * K + C) * 2u; }
    const size_t kstep = (size_t)(BK * 2);
    const size_t hstep = (size_t)HALF * K * 2;
    const size_t tstep = 2 * hstep;
    const unsigned ldsw = (unsigned)wid * 1024u;
    const int aoff = lds_byte(wr * 64 + fr, fq * 8), boff = lds_byte(wc * 32 + fr, fq * 8);
#define PG8_SA(b, h) (((b) * 2 + (h)) * HTB)
#define PG8_SB(b, h) ((4 + (b) * 2 + (h)) * HTB)
#define PG8_STAGE(bufoff, gbase, voff) do { _Pragma("unroll") for (int _i = 0; _i < 2; ++_i) \
        __builtin_amdgcn_global_load_lds((const unsigned*)((const char*)(gbase) + (voff)[_i]), (PG8_LAS unsigned*)(lds + (bufoff) + ldsw + _i * 8192), 16, 0, 0); } while (0)
#define PG8_LDA(dst, b, h) do { _Pragma("unroll") for (int m = 0; m < 4; ++m) _Pragma("unroll") for (int k = 0; k < 2; ++k) dst[m][k] = *(const PG8_LAS bf16x8*)(lds + PG8_SA(b, h) + aoff + m * 2048 + k * 1024); } while (0)
#define PG8_LDB(dst, b, h) do { _Pragma("unroll") for (int n = 0; n < 2; ++n) _Pragma("unroll") for (int k = 0; k < 2; ++k) dst[n][k] = *(const PG8_LAS bf16x8*)(lds + PG8_SB(b, h) + boff + n * 2048 + k * 1024); } while (0)
#define PG8_MMA(ai, bj, At, Bt) do { __builtin_amdgcn_s_setprio(1); _Pragma("unroll") for (int m = 0; m < 4; ++m) _Pragma("unroll") for (int n = 0; n < 2; ++n) _Pragma("unroll") for (int k = 0; k < 2; ++k) \
        acc[ai][bj][m][n] = __builtin_amdgcn_mfma_f32_16x16x32_bf16(Bt[n][k], At[m][k], acc[ai][bj][m][n], 0, 0, 0); __builtin_amdgcn_s_setprio(0); } while (0)
#define PG8_WAIT_V(n) asm volatile("s_waitcnt vmcnt(" #n ")" ::: "memory")
#define PG8_WAIT_L(n) asm volatile("s_waitcnt lgkmcnt(" #n ")" ::: "memory")
#define PG8_BAR __builtin_amdgcn_s_barrier()
#define PG8_SCHED __builtin_amdgcn_sched_barrier(0)
    Unit cur, nxt; int ui = 0;
    if (!S.next(0, cur)) return;
    f32x4 acc[2][2][4][2];
#pragma unroll
    for (int a = 0; a < 2; ++a)
#pragma unroll
        for (int b = 0; b < 2; ++b)
#pragma unroll
            for (int m = 0; m < 4; ++m)
#pragma unroll
                for (int n = 0; n < 2; ++n) acc[a][b][m][n] = (f32x4){0.f, 0.f, 0.f, 0.f};
    bf16x8 At[4][2], B0[2][2], B1[2][2];
    const char* cA = (const char*)g.A + (size_t)cur.pm * tstep + (size_t)cur.kt0 * kstep; const char* cB = (const char*)g.Bt + (size_t)cur.pn * tstep + (size_t)cur.kt0 * kstep;
    S.a_ready(cur);
    if constexpr (SP2) {
        PG8_STAGE(PG8_SB(0, 0), cB, voffB); PG8_STAGE(PG8_SB(0, 1), cB + hstep, voffB); PG8_STAGE(PG8_SA(0, 0), cA, voffA); PG8_STAGE(PG8_SA(0, 1), cA + hstep, voffA);
        if (wr == 1) PG8_BAR;
        PG8_WAIT_V(2); PG8_BAR;
        PG8_STAGE(PG8_SB(1, 0), cB + kstep, voffB); PG8_STAGE(PG8_SA(1, 0), cA + kstep, voffA); PG8_STAGE(PG8_SB(1, 1), cB + hstep + kstep, voffB);
        PG8_WAIT_V(6); PG8_BAR;
    } else {
        PG8_STAGE(PG8_SB(0, 0), cB, voffB); PG8_STAGE(PG8_SA(0, 0), cA, voffA); PG8_STAGE(PG8_SB(0, 1), cB + hstep, voffB); PG8_STAGE(PG8_SA(0, 1), cA + hstep, voffA);
        if (wr == 1) PG8_BAR;
        PG8_WAIT_V(4); PG8_BAR;
        PG8_STAGE(PG8_SB(1, 0), cB + kstep, voffB); PG8_STAGE(PG8_SA(1, 0), cA + kstep, voffA); PG8_STAGE(PG8_SB(1, 1), cB + hstep + kstep, voffB);
        PG8_WAIT_V(6); PG8_BAR;
    }
    for (;;) {
        const bool has_next = S.next(ui + 1, nxt);
        const char* nA = has_next ? (const char*)g.A + (size_t)nxt.pm * tstep + (size_t)nxt.kt0 * kstep : cA; const char* nB = has_next ? (const char*)g.Bt + (size_t)nxt.pn * tstep + (size_t)nxt.kt0 * kstep : cB;
        const int nt = cur.nkt;
        for (int t = 0; t < nt; t += 2) {
            const bool last = (t == nt - 2);
            const char* a1 = cA + (size_t)(t + 1) * kstep;
            const char* a2 = last ? nA : cA + (size_t)(t + 2) * kstep; const char* b2 = last ? nB : cB + (size_t)(t + 2) * kstep;
            const char* a3 = a2 + kstep; const char* b3 = b2 + kstep;
            if (last && has_next) S.a_ready(nxt);
            if constexpr (SP2) {
            PG8_LDB(B0, 0, 0); PG8_LDB(B1, 0, 1); PG8_SCHED; PG8_LDA(At, 0, 0); PG8_STAGE(PG8_SA(1, 1), a1 + hstep, voffA);
            PG8_WAIT_V(8); PG8_WAIT_L(0); PG8_BAR; PG8_MMA(0, 0, At, B0); PG8_MMA(0, 1, At, B1); PG8_BAR; PG8_SCHED;
            PG8_LDA(At, 0, 1); PG8_STAGE(PG8_SB(0, 0), b2, voffB); PG8_STAGE(PG8_SB(0, 1), b2 + hstep, voffB); PG8_STAGE(PG8_SA(0, 0), a2, voffA);
            PG8_WAIT_V(8); PG8_WAIT_L(0); PG8_BAR; PG8_MMA(1, 0, At, B0); PG8_MMA(1, 1, At, B1); PG8_BAR; PG8_SCHED;
            PG8_LDB(B0, 1, 0); PG8_LDB(B1, 1, 1); PG8_SCHED; PG8_LDA(At, 1, 0); PG8_STAGE(PG8_SA(0, 1), a2 + hstep, voffA);
            PG8_WAIT_V(8); PG8_WAIT_L(0); PG8_BAR; PG8_MMA(0, 0, At, B0); PG8_MMA(0, 1, At, B1); PG8_BAR; PG8_SCHED;
            PG8_LDA(At, 1, 1); PG8_STAGE(PG8_SB(1, 0), b3, voffB); PG8_STAGE(PG8_SB(1, 1), b3 + hstep, voffB); PG8_STAGE(PG8_SA(1, 0), a3, voffA);
            PG8_WAIT_V(8); PG8_WAIT_L(0); PG8_BAR; PG8_MMA(1, 0, At, B0); PG8_MMA(1, 1, At, B1); PG8_BAR; PG8_SCHED;
            } else {
            PG8_LDB(B0, 0, 0); PG8_SCHED; PG8_LDA(At, 0, 0); PG8_STAGE(PG8_SA(1, 1), a1 + hstep, voffA);
            PG8_WAIT_L(8); PG8_BAR; PG8_WAIT_L(0); PG8_MMA(0, 0, At, B0); PG8_BAR; PG8_SCHED;
            PG8_LDB(B1, 0, 1); PG8_STAGE(PG8_SB(0, 0), b2, voffB);
            PG8_BAR; PG8_WAIT_L(0); PG8_MMA(0, 1, At, B1); PG8_BAR;
            PG8_LDA(At, 0, 1); PG8_STAGE(PG8_SA(0, 0), a2, voffA);
            PG8_BAR; PG8_WAIT_L(0); PG8_MMA(1, 0, At, B0); PG8_BAR; PG8_SCHED;
            PG8_STAGE(PG8_SB(0, 1), b2 + hstep, voffB);
            PG8_WAIT_V(6); PG8_BAR; PG8_MMA(1, 1, At, B1); PG8_BAR;
            PG8_LDB(B0, 1, 0); PG8_SCHED; PG8_LDA(At, 1, 0); PG8_STAGE(PG8_SA(0, 1), a2 + hstep, voffA);
            PG8_WAIT_L(8); PG8_BAR; PG8_WAIT_L(0); PG8_MMA(0, 0, At, B0); PG8_BAR; PG8_SCHED;
            PG8_LDB(B1, 1, 1); PG8_STAGE(PG8_SB(1, 0), b3, voffB);
            PG8_BAR; PG8_WAIT_L(0); PG8_MMA(0, 1, At, B1); PG8_BAR;
            PG8_LDA(At, 1, 1); PG8_STAGE(PG8_SA(1, 0), a3, voffA);
            PG8_BAR; PG8_WAIT_L(0); PG8_MMA(1, 0, At, B0); PG8_BAR; PG8_SCHED;
            PG8_STAGE(PG8_SB(1, 1), b3 + hstep, voffB);
            PG8_WAIT_V(6); PG8_BAR; PG8_MMA(1, 1, At, B1); PG8_BAR;
            }
        }
        if constexpr (ALIGN_EPI) { if (wr == 0) PG8_BAR; }
        if constexpr (!Epi::AFTER_DRAIN) { E(acc, cur, wr, wc, fr, fq); S.done(cur); }
        if (!has_next) break;
#pragma unroll
        for (int a = 0; a < 2; ++a)
#pragma unroll
            for (int b = 0; b < 2; ++b)
#pragma unroll
                for (int m = 0; m < 4; ++m)
#pragma unroll
                    for (int n = 0; n < 2; ++n) acc[a][b][m][n] = (f32x4){0.f, 0.f, 0.f, 0.f};
        cur = nxt; cA = nA; cB = nB; ++ui;
        if constexpr (ALIGN_EPI) { if (wr == 1) PG8_BAR; }
    }
    PG8_WAIT_V(0);
    if constexpr (!ALIGN_EPI) { if (wr == 0) PG8_BAR; }
    PG8_BAR;
    if constexpr (Epi::AFTER_DRAIN) { E.fused(acc, cur, wr, wc, fr, fq, lds, wid, lane); S.done(cur); }
#undef PG8_SA
#undef PG8_SB
#undef PG8_STAGE
#undef PG8_LDA
#undef PG8_LDB
#undef PG8_MMA
#undef PG8_WAIT_V
#undef PG8_WAIT_L
#undef PG8_BAR
#undef PG8_SCHED
}
}

namespace att {
typedef unsigned short bf16;
typedef short bf16x8 __attribute__((ext_vector_type(8)));
typedef short s16x4 __attribute__((ext_vector_type(4)));
typedef float f32x16 __attribute__((ext_vector_type(16)));
typedef float f32x4 __attribute__((ext_vector_type(4)));
typedef unsigned u32x4 __attribute__((ext_vector_type(4)));
constexpr int D = 128, NW = 8, QBLK = 32, KVBLK = 64, QB = NW * QBLK, LD = 2048;
constexpr int SHM_V = KVBLK * D * 2, SHM_K = KVBLK * D * 2;
constexpr int QPMAX = 7;
template <class T> struct QPark { static constexpr int N = 3; };
template <> struct QPark<float> { static constexpr int N = 7; };
constexpr int OFF_WS = 2 * SHM_V + 2 * SHM_K, WS_WAVE = 768, OFF_QP = OFF_WS + NW * WS_WAVE, LDS_BYTES = OFF_QP + QPMAX * 64 * NW * 16;
constexpr float SCALE = 0.08838834764831845f, THR = 8.f, L2E = 1.4426950408889634f;
template <class A, class Bt> struct same_t { static constexpr bool v = false; };
template <class A> struct same_t<A, A> { static constexpr bool v = true; };
#define KSWZ(row, colB) ((row) * 256 + ((colB) ^ (((row) & 7) << 4)))
#define SBAR() __builtin_amdgcn_sched_barrier(0)
__device__ __forceinline__ int v_st(int k, int c) { const int kk = (k & ~0xC) | ((k & 4) << 1) | ((k & 8) >> 1); return ((kk >> 3) * 4 + (c >> 5)) * 512 + ((kk & 7) * 32 + (c & 31)) * 2; }
__device__ __forceinline__ int v_rd_base(int lane) { return ((lane & 3) << 3) | (((lane >> 2) & 3) << 6) | (((lane >> 4) & 1) << 5) | (((lane >> 5) & 1) << 8); }
constexpr int v_rd_off(int d0, int ks, int half) { return d0 * 512 + ks * 4096 + half * 2048; }
__device__ __forceinline__ int crow(int r, int hi) { return (r & 3) + 8 * (r >> 2) + 4 * hi; }
__device__ __forceinline__ unsigned cvtpk(float lo, float hi) { unsigned r; asm volatile("v_cvt_pk_bf16_f32 %0, %1, %2" : "=v"(r) : "v"(lo), "v"(hi)); return r; }
__device__ __forceinline__ bf16x8 pack8(f32x4 a, f32x4 b) { u32x4 w = {cvtpk(a[0], a[1]), cvtpk(a[2], a[3]), cvtpk(b[0], b[1]), cvtpk(b[2], b[3])}; return *reinterpret_cast<bf16x8*>(&w); }
template <class T> __device__ __forceinline__ const __attribute__((address_space(1))) T* uni(const T* p) {
    const unsigned long long v = (unsigned long long)p; const unsigned lo = (unsigned)__builtin_amdgcn_readfirstlane((int)(unsigned)v), hi = (unsigned)__builtin_amdgcn_readfirstlane((int)(unsigned)(v >> 32));
    return (const __attribute__((address_space(1))) T*)(((unsigned long long)hi << 32) | lo);
}
template <class T> __device__ __forceinline__ bf16x8 load8(const __attribute__((address_space(1))) T* p) {
    if constexpr (same_t<T, float>::v) { return pack8(*(const __attribute__((address_space(1))) f32x4*)p, *(const __attribute__((address_space(1))) f32x4*)(p + 4)); }
    else { return *reinterpret_cast<const __attribute__((address_space(1))) bf16x8*>(p); }
}
template <class T> __device__ __forceinline__ bf16x8 load8(const T* p) {
    if constexpr (same_t<T, float>::v) { return pack8(*(const f32x4*)p, *(const f32x4*)(p + 4)); }
    else { return *reinterpret_cast<const bf16x8*>(p); }
}
__device__ __forceinline__ void mask_tile(f32x16& p0, f32x16& p1, int dq) {
    const float NEG = -__builtin_inff();
#pragma unroll
    for (int r = 0; r < 16; ++r) { const int c = (r & 3) + 8 * (r >> 2); if (dq - c < 0) p0[r] = NEG; if (dq - c - 32 < 0) p1[r] = NEG; }
}
__device__ __forceinline__ void partialSM(f32x16& p0, f32x16& p1, float& m_reg, float& mn, float& alpha) {
    float pmax = p0[0];
#pragma unroll
    for (int r = 1; r < 16; ++r) pmax = fmaxf(pmax, p0[r]);
#pragma unroll
    for (int r = 0; r < 16; ++r) pmax = fmaxf(pmax, p1[r]);
    { auto rr = __builtin_amdgcn_permlane32_swap(__float_as_uint(pmax), __float_as_uint(pmax), false, false); pmax = fmaxf(__uint_as_float(rr[0]), __uint_as_float(rr[1])); }
    constexpr float C2 = L2E * SCALE, THR2 = THR * L2E;
    const float pm = pmax * C2;
    if (__builtin_expect(__all(pm - m_reg <= THR2), 1)) { mn = m_reg; alpha = 1.f; }
    else { mn = fmaxf(m_reg, pm); alpha = __builtin_amdgcn_exp2f(m_reg - mn); m_reg = mn; }
    const float mnL = -mn;
#pragma unroll
    for (int r = 0; r < 16; ++r) p0[r] = fmaf(p0[r], C2, mnL);
#pragma unroll
    for (int r = 0; r < 16; ++r) p1[r] = fmaf(p1[r], C2, mnL);
#pragma unroll
    for (int r = 0; r < 16; ++r) p0[r] = __builtin_amdgcn_exp2f(p0[r]);
}
__device__ __forceinline__ void finishSM(f32x16& p0, f32x16& p1, float alpha, float& l_reg, bf16x8& pa0, bf16x8& pa1, bf16x8& pa2, bf16x8& pa3) {
#pragma unroll
    for (int r = 0; r < 16; ++r) p1[r] = __builtin_amdgcn_exp2f(p1[r]);
    float ps = 0;
#pragma unroll
    for (int r = 0; r < 16; ++r) ps += p0[r];
#pragma unroll
    for (int r = 0; r < 16; ++r) ps += p1[r];
    { auto rr = __builtin_amdgcn_permlane32_swap(__float_as_uint(ps), __float_as_uint(ps), false, false); ps = __uint_as_float(rr[0]) + __uint_as_float(rr[1]); }
    l_reg = l_reg * alpha + ps;
#define PK4(P, B_, OUT) do { unsigned a0 = cvtpk(P[B_+0], P[B_+1]), a1 = cvtpk(P[B_+2], P[B_+3]);                          \
        unsigned b0 = cvtpk(P[B_+4], P[B_+5]), b1 = cvtpk(P[B_+6], P[B_+7]);                                             \
        auto r0 = __builtin_amdgcn_permlane32_swap(a0, b0, false, false); auto r1 = __builtin_amdgcn_permlane32_swap(a1, b1, false, false); \
        u32x4 w = {r0[0], r1[0], r0[1], r1[1]}; OUT = *reinterpret_cast<bf16x8*>(&w); } while (0)
    PK4(p0, 0, pa0); PK4(p0, 8, pa1); PK4(p1, 0, pa2); PK4(p1, 8, pa3);
#undef PK4
}
template <int KB, int QP>
__device__ __forceinline__ void qkt(f32x16& p0, f32x16& p1, const char* K_lds, const char* wl, int r32, int hi, const bf16x8* qr, const char* qp) {
#pragma unroll
    for (int g = 0; g < 4; ++g) { const f32x4 a = *reinterpret_cast<const f32x4*>(wl + 256 + KB * 256 + g * 32), b = *reinterpret_cast<const f32x4*>(wl + 256 + KB * 256 + 128 + g * 32);
        p0[4 * g] = a[0]; p0[4 * g + 1] = a[1]; p0[4 * g + 2] = a[2]; p0[4 * g + 3] = a[3]; p1[4 * g] = b[0]; p1[4 * g + 1] = b[1]; p1[4 * g + 2] = b[2]; p1[4 * g + 3] = b[3]; }
    const char* kb[4];
#pragma unroll
    for (int dd = 0; dd < 4; ++dd) kb[dd] = K_lds + KB * SHM_K + KSWZ(r32, (dd * 16 + hi * 8) * 2);
#pragma unroll
    for (int d0 = 0; d0 < 8; ++d0) { const char* a = kb[d0 & 3] + (d0 >> 2) * 128;
        bf16x8 b0 = *reinterpret_cast<const bf16x8*>(a);
        bf16x8 b1 = *reinterpret_cast<const bf16x8*>(a + 32 * 256);
        const bf16x8 q = d0 < 8 - QP ? qr[d0] : *reinterpret_cast<const bf16x8*>(qp + (d0 - (8 - QP)) * (64 * NW * 16));
        p0 = __builtin_amdgcn_mfma_f32_32x32x16_bf16(b0, q, p0, 0, 0, 0);
        p1 = __builtin_amdgcn_mfma_f32_32x32x16_bf16(b1, q, p1, 0, 0, 0); }
}
template <int VB>
__device__ __forceinline__ void pv_tile(f32x16* o, int vb0, bf16x8 pa0, bf16x8 pa1, bf16x8 pa2, bf16x8 pa3) {
#define TRRD(dst, off) asm volatile("ds_read_b64_tr_b16 %0, %1 offset:%2" : "=&v"(dst) : "v"(vb0), "i"(off) : "memory")
#define PV_D0(d0) do { s16x4 l0, l1, l2, l3, h0, h1, h2, h3; constexpr int b_ = VB * SHM_V + v_rd_off(d0, 0, 0);   \
        TRRD(l0, b_); TRRD(h0, b_ + 2048); TRRD(l1, b_ + 4096); TRRD(h1, b_ + 6144); TRRD(l2, b_ + 8192); TRRD(h2, b_ + 10240); TRRD(l3, b_ + 12288); TRRD(h3, b_ + 14336); \
        asm volatile("s_waitcnt lgkmcnt(0)" ::: "memory"); SBAR();   \
        o[d0] = __builtin_amdgcn_mfma_f32_32x32x16_bf16(pa0, (bf16x8){l0[0], l0[1], l0[2], l0[3], h0[0], h0[1], h0[2], h0[3]}, o[d0], 0, 0, 0);   \
        o[d0] = __builtin_amdgcn_mfma_f32_32x32x16_bf16(pa1, (bf16x8){l1[0], l1[1], l1[2], l1[3], h1[0], h1[1], h1[2], h1[3]}, o[d0], 0, 0, 0);   \
        o[d0] = __builtin_amdgcn_mfma_f32_32x32x16_bf16(pa2, (bf16x8){l2[0], l2[1], l2[2], l2[3], h2[0], h2[1], h2[2], h2[3]}, o[d0], 0, 0, 0);   \
        o[d0] = __builtin_amdgcn_mfma_f32_32x32x16_bf16(pa3, (bf16x8){l3[0], l3[1], l3[2], l3[3], h3[0], h3[1], h3[2], h3[3]}, o[d0], 0, 0, 0); } while (0)
    PV_D0(0); PV_D0(1); PV_D0(2); PV_D0(3);
#undef PV_D0
#undef TRRD
}
template <class TIn> struct BlockRef { unsigned q, k, v, k2, v2, nf, o; int P0, skv, qrows, split; };
struct KVBase { const char* k1; const char* v1; const char* kv2; };
#define BQ(ref) ((const bf16*)(wsb + (ref).q))
#define BK(ref) ((const TIn*)(kvb.k1 + (ref).k))
#define BV(ref) ((const TIn*)(kvb.v1 + (ref).v))
#define BNF(ref) ((const float*)(wsb + (ref).nf))
template <class T> struct Stg { bf16x8 v; __device__ __forceinline__ void ld(const __attribute__((address_space(1))) T* p) { v = *reinterpret_cast<const __attribute__((address_space(1))) bf16x8*>(p); } __device__ __forceinline__ bf16x8 get() const { return v; } };
template <> struct Stg<float> { f32x4 a, b; __device__ __forceinline__ void ld(const __attribute__((address_space(1))) float* p) { a = *(const __attribute__((address_space(1))) f32x4*)p; b = *(const __attribute__((address_space(1))) f32x4*)(p + 4); } __device__ __forceinline__ bf16x8 get() const { return pack8(a, b); } };
template <class TIn> struct Seam {
    bf16x8 qr[8];
    Stg<TIn> st_v0, st_v1, st_k0, st_k1;
    float st_nf;
};
#define ROW(p, k0, rr) (uni((p) + (size_t)((k0) + (rr)) * LD) + lane_kv)
#define VMW() asm volatile("s_waitcnt vmcnt(0)" ::: "memory")
#define VMWN(n) asm volatile("s_waitcnt vmcnt(%0)" :: "i"(n) : "memory")
#define SLOAD_H(Kp, Vp, k0) do { S.st_v0.ld(ROW(Vp, k0, 0)); S.st_v1.ld(ROW(Vp, k0, 32)); S.st_k0.ld(ROW(Kp, k0, 0)); S.st_k1.ld(ROW(Kp, k0, 32)); } while (0)
#define SWRITE_HK(bf) do { *(bf16x8*)(K_lds + (bf) * SHM_K + kws) = S.st_k0.get(); *(bf16x8*)(K_lds + (bf) * SHM_K + kws + 32 * 256) = S.st_k1.get(); } while (0)
#define SWRITE_HV(bf) do { *(bf16x8*)(V_lds + (bf) * SHM_V + vst0) = S.st_v0.get(); *(bf16x8*)(V_lds + (bf) * SHM_V + vst1) = S.st_v1.get(); } while (0)
#define NFLOAD(ref, k0) do { S.st_nf = BNF(ref)[(k0) + lane]; } while (0)
#define NFWRITE(bf) do { nf_l[(bf) * 64 + lane] = S.st_nf; } while (0)
#define KSRC(ref, k0) ((k0) >= (ref).split ? (const TIn*)(kvb.kv2 + (ref).k2) : BK(ref))
#define VSRC(ref, k0) ((k0) >= (ref).split ? (const TIn*)(kvb.kv2 + (ref).v2) : BV(ref))
template <class TIn>
__device__ __forceinline__ int fox_jlo(const char* wsb, const BlockRef<TIn>& r, float D, int lane) {
    int j_hi = (r.P0 + QB - 1) / KVBLK + 1; if (j_hi > r.skv / KVBLK) j_hi = r.skv / KVBLK;
    const float* nf = (const float*)(wsb + r.nf);
    const float ref = nf[r.P0] - D; const int j = lane < j_hi ? lane : j_hi - 1;
    const unsigned long long keep = __ballot(nf[KVBLK * j + KVBLK - 1] >= ref);
    int jl = keep ? __builtin_ctzll(keep) : 0; const int jd = r.P0 / KVBLK;
    jl = jl < jd ? jl : jd;
    return __builtin_amdgcn_readfirstlane(jl);
}
template <class TIn>
__device__ __forceinline__ void fox_prime(const char* wsb, const KVBase& kvb, const BlockRef<TIn>& cur, float Dskip, char* lds, Seam<TIn>& S) {
    const int tid = threadIdx.x, wid = __builtin_amdgcn_readfirstlane(tid >> 6), lane = tid & 63, r32 = lane & 31, hi = lane >> 5;
    const int sr = tid >> 4, sc = (tid & 15) * 8, kws = KSWZ(sr, sc * 2); char* K_lds = lds + 2 * SHM_V; float* nf_l = (float*)(lds + OFF_WS + wid * WS_WAVE + 256);
    const unsigned lane_kv = (unsigned)(sr * LD + sc), lane_q = (unsigned)(r32 * LD + hi * 8);
    const int qrow0 = wid * QBLK < cur.qrows ? wid * QBLK : 0;
    for (int d0 = 0; d0 < 8; ++d0) S.qr[d0] = load8<bf16>(uni(BQ(cur) + (size_t)qrow0 * LD + d0 * 16) + lane_q);
    const int kb0 = fox_jlo<TIn>(wsb, cur, Dskip, lane) * KVBLK;
    NFLOAD(cur, kb0);
    SLOAD_H(KSRC(cur, kb0), VSRC(cur, kb0), kb0); VMW(); SWRITE_HK(0); NFWRITE(0);
    __syncthreads();
}
template <class TIn>
__device__ __forceinline__ void fox_block(const char* wsb, char* wsw, const KVBase& kvb, const BlockRef<TIn>& cur, const BlockRef<TIn>& nxt, float Dskip, char* lds, Seam<TIn>& S) {
    constexpr int QP = QPark<TIn>::N;
    const int tid = threadIdx.x, wid = __builtin_amdgcn_readfirstlane(tid >> 6), lane = tid & 63, r32 = lane & 31, hi = lane >> 5;
    int j_hi = (cur.P0 + QB - 1) / KVBLK + 1; if (j_hi > cur.skv / KVBLK) j_hi = cur.skv / KVBLK;
    const int j_lo = fox_jlo<TIn>(wsb, cur, Dskip, lane), NT = j_hi - j_lo;
    const int qlo = cur.P0 + wid * QBLK, qm = qlo + r32 - 4 * hi;
    char* V_lds = lds; char* K_lds = lds + 2 * SHM_V;
    char* wsw_l = lds + OFF_WS + wid * WS_WAVE; float* li_l = (float*)wsw_l, * al_l = (float*)(wsw_l + 128), * nf_l = (float*)(wsw_l + 256);
    const char* wl = wsw_l + hi * 16;
    float m_reg = -1e30f, l_reg = 0; f32x16 o[4] = {};
    const int sr = tid >> 4, sc = (tid & 15) * 8, vst0 = v_st(sr, sc), vst1 = v_st(32 + sr, sc), kws = KSWZ(sr, sc * 2);
    const int vb0 = (int)(uintptr_t)V_lds + v_rd_base(lane);
    const unsigned lane_kv = (unsigned)(sr * LD + sc), lane_q = (unsigned)(r32 * LD + hi * 8);
    const bool wlive = wid * QBLK < cur.qrows;
    char* qp = lds + OFF_QP + tid * 16;
#pragma unroll
    for (int j = 0; j < QP; ++j) *reinterpret_cast<bf16x8*>(qp + j * (64 * NW * 16)) = S.qr[8 - QP + j];
#define RESC(a) do { if (__any((a) < 1.f)) { if (hi == 0) al_l[r32] = (a); asm volatile("s_waitcnt lgkmcnt(0)" ::: "memory");              \
                     for (int d_ = 0; d_ < 4; ++d_) for (int r = 0; r < 16; ++r) o[d_][r] *= *(const float*)(wl + 128 + 4 * ((r & 3) + 8 * (r >> 2))); } } while (0)
#define KBASE(t) ((j_lo + (t)) * KVBLK)
#define MASKT(P0_, P1_, t) do { const int kb_ = KBASE(t); if (kb_ + KVBLK - 1 > qlo) mask_tile(P0_, P1_, qm - kb_); } while (0)
    constexpr int NQL = 8;
#define SEAM_K0() do { VMWN(NQL); SWRITE_HK(0); NFWRITE(0); SBAR(); } while (0)
    f32x16 pA0, pA1, pB0, pB1; float mnA, mnB, alA, alB; bf16x8 pa0, pa1, pa2, pa3;
    SWRITE_HV(0); SBAR();
    if (NT > 1) { NFLOAD(cur, KBASE(1)); SLOAD_H(KSRC(cur, KBASE(1)), VSRC(cur, KBASE(1)), KBASE(1)); }
    SBAR(); if (wlive) { qkt<0, QP>(pA0, pA1, K_lds, wl, r32, hi, S.qr, qp);
    MASKT(pA0, pA1, 0); partialSM(pA0, pA1, m_reg, mnA, alA); }
    if (NT > 1) { VMW(); SWRITE_HV(1); SWRITE_HK(1); NFWRITE(1); }
    __syncthreads();
#define HALF_STEP(PX0, PX1, mnX, alX, PY0, PY1, alY, t, KB, VB, SB) do {                                                      \
        SBAR(); if (wlive) { qkt<KB, QP>(PX0, PX1, K_lds, wl, r32, hi, S.qr, qp);                                              \
        finishSM(PY0, PY1, alY, l_reg, pa0, pa1, pa2, pa3); } SBAR();                                                         \
        if ((t) + 1 < NT) { NFLOAD(cur, KBASE((t) + 1)); SLOAD_H(KSRC(cur, KBASE((t) + 1)), VSRC(cur, KBASE((t) + 1)), KBASE((t) + 1)); SBAR(); }          \
        if (wlive) { pv_tile<VB>(o, vb0, pa0, pa1, pa2, pa3); MASKT(PX0, PX1, (t)); partialSM(PX0, PX1, m_reg, mnX, alX); }    \
        __syncthreads();                                                                                                      \
        if ((t) + 1 < NT) { VMW(); SWRITE_HV(SB); SWRITE_HK(SB); NFWRITE(SB); }                                             \
        if (wlive) RESC(alX); __syncthreads(); } while (0)
    for (int t = 1; t + 1 < NT; t += 2) {
        HALF_STEP(pB0, pB1, mnB, alB, pA0, pA1, alA, t, 1, 0, 0);
        HALF_STEP(pA0, pA1, mnA, alA, pB0, pB1, alB, t + 1, 0, 1, 1);
    }
    const bool even = (NT & 1) == 0;
    if (even) { SBAR(); if (wlive) qkt<1, QP>(pB0, pB1, K_lds, wl, r32, hi, S.qr, qp); SBAR(); }
    const int qrown0 = wid * QBLK < nxt.qrows ? wid * QBLK : 0;
    const int kbn = fox_jlo<TIn>(wsb, nxt, Dskip, lane) * KVBLK;
    NFLOAD(nxt, kbn);
    SLOAD_H(KSRC(nxt, kbn), VSRC(nxt, kbn), kbn);
    SBAR();
#pragma unroll
    for (int d0 = 0; d0 < 8; ++d0) S.qr[d0] = load8<bf16>(uni(BQ(nxt) + (size_t)qrown0 * LD + d0 * 16) + lane_q);
    SBAR();
    if (wlive) { finishSM(pA0, pA1, alA, l_reg, pa0, pa1, pa2, pa3); } SBAR();
    if (wlive) pv_tile<0>(o, vb0, pa0, pa1, pa2, pa3);
    if (even) { if (wlive) { MASKT(pB0, pB1, NT - 1); partialSM(pB0, pB1, m_reg, mnB, alB); } __syncthreads(); if (wlive) { RESC(alB);
        finishSM(pB0, pB1, alB, l_reg, pa0, pa1, pa2, pa3); } SBAR(); if (wlive) pv_tile<1>(o, vb0, pa0, pa1, pa2, pa3); }
    SBAR(); SEAM_K0();
    if (hi == 0) li_l[r32] = l_reg; asm volatile("s_waitcnt lgkmcnt(0)" ::: "memory");
    float rli[16];
#pragma unroll
    for (int r = 0; r < 16; ++r) rli[r] = __builtin_amdgcn_rcpf(*(const float*)(wl + 4 * ((r & 3) + 8 * (r >> 2))));
    bf16* Ow = (bf16*)(wsw + cur.o) + (size_t)(wid * QBLK) * LD; const unsigned lane_o = (unsigned)(4 * hi * LD + r32);
    if (wlive) {
#pragma unroll
    for (int r = 0; r < 16; ++r) { bf16* Or = Ow + (size_t)((r & 3) + 8 * (r >> 2)) * LD;
#pragma unroll
        for (int d0 = 0; d0 < 4; ++d0) { const float v = o[d0][r] * rli[r]; const float vn = __shfl_xor(v, 1);
            if ((r32 & 1) == 0) *(unsigned*)(Or + d0 * 32 + lane_o) = cvtpk(v, vn); } } }
    __syncthreads();
#undef RESC
#undef KBASE
#undef MASKT
#undef SEAM_K0
#undef HALF_STEP
}
#undef ROW
#undef VMW
#undef VMWN
#undef SLOAD_H
#undef SWRITE_HK
#undef SWRITE_HV
#undef NFLOAD
#undef NFWRITE
#undef KSRC
#undef VSRC
#undef BQ
#undef BK
#undef BV
#undef BNF
#undef KSWZ
#undef SBAR
}


constexpr int DM = 4096, DFF = 11008, NPR = 8192, NSR = 2048, MR = NPR + NSR;
constexpr int SEQ = 4096, NBP = 2, NBS = 32, TS = 64, PAST = 1024, SKVS = PAST + TS;
constexpr int NH = 16, HD = 128, DA = 2048, DS = 2048, NG = 128, SG = 16, NP = 64, NIN = 8208;
constexpr float EPS = 1e-6f;
constexpr int NWAVES = 8;
constexpr int N_PHASES = 15;
#ifndef GEMM_ALIGN
#define GEMM_ALIGN true
#endif
#ifndef GEMM_SP2
#define GEMM_SP2 true
#endif
#ifndef P8_HOSTS_OB_NORM
#define P8_HOSTS_OB_NORM 1
#endif
#ifndef P7_ROTATE
#define P7_ROTATE 3
#endif
#ifndef P2_HOSTS_CONVERSION
#define P2_HOSTS_CONVERSION 1
#endif
#ifndef MK_ONE_LAUNCH
#define MK_ONE_LAUNCH 1
#endif

constexpr size_t O_Y = 0, O_KP = (size_t)MR * DM, O_VP = O_KP + (size_t)NPR * DA, O_LP = O_VP + (size_t)NPR * DA, O_SRP = O_LP + (size_t)NPR * NH, O_SIP = O_SRP + NBP * NG * NP,
                 O_KS = O_SIP + NBP * NG * NP, O_VS = O_KS + (size_t)NSR * DA, O_LS = O_VS + (size_t)NSR * DA, O_SRS = O_LS + (size_t)NSR * NH, O_SIS = O_SRS + NBS * NG * NP, O_END = O_SIS + NBS * NG * NP;
static_assert(O_END == 84606976, "output size");

constexpr size_t MiB = 1u << 20;
constexpr size_t WS_CTL = 0, CTL_ZERO_BYTES = 32768;
constexpr size_t WS_W13A = 2 * MiB;
constexpr size_t WS_W2A = WS_W13A + 172 * MiB;
constexpr size_t WS_W13B = WS_W2A + 86 * MiB;
constexpr size_t WS_W2B = WS_W13B + 172 * MiB;
constexpr size_t WS_WIN = WS_W2B + 86 * MiB;
constexpr size_t WS_WF = WS_WIN + 64 * MiB;
constexpr size_t WS_WGLU = WS_WF + 1 * MiB;
constexpr size_t WS_WOUT = WS_WGLU + 8 * MiB;
constexpr size_t WS_XN = WS_WOUT + 32 * MiB;
constexpr size_t WS_H = WS_XN + 80 * MiB;
constexpr size_t WS_ZQ = WS_H;
constexpr size_t WS_ZK = WS_H + 80 * MiB;
constexpr size_t WS_QN = WS_H + 160 * MiB;
constexpr size_t WS_U = WS_H + 215 * MiB;
constexpr size_t WS_OB = WS_U + 80 * MiB;
constexpr size_t WS_YS = WS_OB + 40 * MiB;
constexpr size_t WS_YG = WS_YS + 40 * MiB;
constexpr size_t WS_KBP = WS_YG + 40 * MiB;
constexpr size_t WS_VBP = WS_KBP + 32 * MiB;
constexpr size_t WS_KBS = WS_VBP + 32 * MiB;
constexpr size_t WS_VBS = WS_KBS + 136 * MiB;
constexpr size_t WS_NFP = WS_VBS + 136 * MiB;
constexpr size_t WS_FQP = WS_NFP + 1 * MiB;
constexpr size_t WS_NFS = WS_FQP + 1 * MiB;
constexpr size_t WS_FQS = WS_NFS + 3 * MiB;
constexpr size_t WS_LAMB = WS_FQS + 1 * MiB;
constexpr size_t WS_LAM64 = WS_LAMB + 1 * MiB;
constexpr size_t WS_BB = WS_LAM64 + 1 * MiB;
constexpr size_t WS_CC = WS_BB + 1 * MiB;
constexpr size_t WS_SLOC = WS_CC + 1 * MiB;
constexpr size_t WS_XIN = WS_SLOC + 8 * MiB;
constexpr size_t WS_S2 = WS_XIN + 8 * MiB;
constexpr size_t WS_END = WS_S2 + 32 * MiB;
static_assert(WS_END <= 1900 * MiB && WS_END < 0xFFFFFFFFull, "workspace map (the attention body addresses it with 32-bit byte offsets)");
constexpr int CW_BAR = 4096;

constexpr int RING_OFF = 0, RING_BYTES = 131072;
constexpr int LDSCTL_OFF = RING_BYTES, MISC_OFF = LDSCTL_OFF + 320;
constexpr int LDS_BYTES = 147456;

#define GAS __attribute__((address_space(1)))
#define LAS __attribute__((address_space(3)))
typedef unsigned short bf16;
typedef unsigned v4u __attribute__((ext_vector_type(4)));
typedef unsigned v2u __attribute__((ext_vector_type(2)));
typedef float f32x4 __attribute__((ext_vector_type(4)));
typedef short bf16x8 __attribute__((ext_vector_type(8)));
#define LDS_WAIT() asm volatile("s_waitcnt lgkmcnt(0)" ::: "memory")
#define VM_WAIT() asm volatile("s_waitcnt vmcnt(0)" ::: "memory")
__device__ __forceinline__ unsigned pk2(float lo, float hi) { unsigned r; asm volatile("v_cvt_pk_bf16_f32 %0, %1, %2" : "=v"(r) : "v"(lo), "v"(hi)); return r; }
__device__ __forceinline__ float bf_lo(unsigned w) { return __uint_as_float(w << 16); }
__device__ __forceinline__ float bf_hi(unsigned w) { return __uint_as_float(w & 0xffff0000u); }

#define XB_TMO      128
#define XB_XCNT(j)  (256  + 64 * (j))
#define XB_XSUB(j)  (1280 + 64 * (j))
#define XB_XGEN(j)  (2304 + 64 * (j))
#define XB_TOP      3328
#define XB_TOPGEN   3392
#define XCD_BAR_WORDS 3456
#define XB_SPIN_CAP (1u << 18)

__device__ __forceinline__ unsigned xb_ld(unsigned* p)              { return __hip_atomic_load(p, __ATOMIC_RELAXED, __HIP_MEMORY_SCOPE_AGENT); }
__device__ __forceinline__ unsigned xb_add(unsigned* p, unsigned v) { return __hip_atomic_fetch_add(p, v, __ATOMIC_RELAXED, __HIP_MEMORY_SCOPE_AGENT); }
__device__ __forceinline__ unsigned xb_xcc_id() { return (unsigned)__builtin_amdgcn_s_getreg((3 << 11) | 20) & 0xFu; }
#define XB_SPIN(cond, bar) do { unsigned _sp = 0; while (cond) { __builtin_amdgcn_s_sleep(1); \
    if ((++_sp & 255u) == 0u) { if (xb_ld(&(bar)[XB_TMO])) break; if (_sp > XB_SPIN_CAP) { atomicAdd(&(bar)[XB_TMO], 1u); break; } } } } while (0)

struct XcdBarrier {
    unsigned* bar; unsigned x;
    volatile LAS unsigned* st;
};

__device__ __forceinline__ XcdBarrier xcd_barrier_post(unsigned* bar, volatile LAS unsigned* st) {
    XcdBarrier b; b.bar = bar; b.x = xb_xcc_id(); b.st = st;
    if (threadIdx.x == 0) (void)xb_add(&bar[XB_XCNT(b.x)], 1u);
    return b;
}
__device__ __forceinline__ void xcd_barrier_complete(unsigned* bar, unsigned x, unsigned& nloc, unsigned& nx) {
    const unsigned G = gridDim.x * gridDim.y * gridDim.z;
    unsigned sum, cnt, mine, sp = 0u;
    for (;;) {
        sum = 0u; cnt = 0u; mine = 0u;
#pragma unroll
        for (unsigned j = 0; j < 16; ++j) { const unsigned c = xb_ld(&bar[XB_XCNT(j)]); sum += c; cnt += (c > 0u) ? 1u : 0u; mine = (j == x) ? c : mine; }
        if (sum == G) break;
        __builtin_amdgcn_s_sleep(1);
        if ((++sp & 255u) == 0u) { if (xb_ld(&bar[XB_TMO])) break; if (sp > XB_SPIN_CAP) { atomicAdd(&bar[XB_TMO], 1u); break; } }
    }
    nloc = mine > 0u ? mine : 1u; nx = cnt > 0u ? cnt : 1u;
}

__device__ __forceinline__ void xcd_barrier(const XcdBarrier& b) {
    asm volatile("s_waitcnt vmcnt(0)" ::: "memory");
    __syncthreads();
    if (threadIdx.x == 0) {
        unsigned* bar = b.bar;
        __builtin_amdgcn_s_waitcnt(0);
        unsigned nloc = b.st[0], nx = b.st[1];
        if (nloc == 0u) { xcd_barrier_complete(bar, b.x, nloc, nx); b.st[0] = nloc; b.st[1] = nx; }
        const unsigned old = xb_add(&bar[XB_XSUB(b.x)], 1u);
        const unsigned gen = old / nloc;
        if (old + 1u == (gen + 1u) * nloc) {
            __builtin_amdgcn_fence(__ATOMIC_RELEASE, "agent");
            asm volatile("s_waitcnt vmcnt(0)" ::: "memory");
            const unsigned og = xb_add(&bar[XB_TOP], 1u);
            const unsigned tg = og / nx;
            if (og + 1u == (tg + 1u) * nx) xb_add(&bar[XB_TOPGEN], 1u);
            else XB_SPIN(xb_ld(&bar[XB_TOPGEN]) == tg, bar);
            __builtin_amdgcn_fence(__ATOMIC_ACQUIRE, "agent");
            xb_add(&bar[XB_XGEN(b.x)], 1u);
            asm volatile("s_waitcnt vmcnt(0)" ::: "memory");
        } else {
            XB_SPIN(xb_ld(&bar[XB_XGEN(b.x)]) == gen, bar);
            __builtin_amdgcn_fence(__ATOMIC_ACQUIRE, "agent");
            asm volatile("s_waitcnt vmcnt(0)" ::: "memory");
        }
    }
    __syncthreads();
}

constexpr int QKTAB_OFF = LDSCTL_OFF + 1024;
constexpr int ARGTAB_OFF = LDSCTL_OFF + 512;
__device__ __forceinline__ const float* inp_ptr(LAS unsigned char* lds, int i) {
    const LAS unsigned* t = (const LAS unsigned*)(lds + ARGTAB_OFF) + 2 * i;
    const unsigned lo = (unsigned)__builtin_amdgcn_readfirstlane((int)t[0]), hi = (unsigned)__builtin_amdgcn_readfirstlane((int)t[1]);
    return (const float*)(const GAS float*)(((unsigned long long)hi << 32) | lo);
}
struct Wv { int lane, wave, gw, ngw; };
__device__ __forceinline__ float wave_sum(float v) {
#pragma unroll
    for (int o = 1; o < 64; o <<= 1) v += __shfl_xor(v, o);
    return v;
}
__device__ __forceinline__ float fsig(float x) { return __builtin_amdgcn_rcpf(1.0f + __builtin_amdgcn_exp2f(-1.4426950408889634f * x)); }
__device__ __forceinline__ bf16x8 pack8f(f32x4 a, f32x4 b) { v4u w = {pk2(a[0], a[1]), pk2(a[2], a[3]), pk2(b[0], b[1]), pk2(b[2], b[3])}; return *reinterpret_cast<bf16x8*>(&w); }

__device__ __forceinline__ void transpose_item(const float* W, int ldw, int K, int k0, int nsrc0, bf16* WT, int drow0, LAS float* scr, int lane) {
#pragma unroll 8
    for (int i = 0; i < 32; ++i) { const int kk = 2 * i + (lane >> 5); scr[kk * 33 + (lane & 31)] = __builtin_nontemporal_load(W + (size_t)(k0 + kk) * ldw + nsrc0 + (lane & 31)); }
    LDS_WAIT(); asm volatile("" ::: "memory");
    const int c = lane & 7;
#pragma unroll
    for (int j = 0; j < 4; ++j) { const int n = (lane >> 3) + 8 * j; const LAS float* s = scr + (8 * c) * 33 + n;
        v4u o; o.x = pk2(s[0 * 33], s[1 * 33]); o.y = pk2(s[2 * 33], s[3 * 33]); o.z = pk2(s[4 * 33], s[5 * 33]); o.w = pk2(s[6 * 33], s[7 * 33]);
        *(GAS v4u*)(WT + (size_t)(drow0 + n) * K + k0 + 8 * c) = o; }
    LDS_WAIT(); asm volatile("" ::: "memory");
}
__device__ __forceinline__ void rms_row_4096(float* xrow, const float* addrow, const float* gain, bf16* orow, int lane) {
    GAS f32x4* xr = (GAS f32x4*)xrow + lane;
    f32x4 v[16]; float s = 0.f;
    if (addrow) { const GAS f32x4* ar = (const GAS f32x4*)addrow + lane;
#pragma unroll
        for (int j = 0; j < 16; ++j) { v[j] = xr[64 * j] + ar[64 * j]; xr[64 * j] = v[j]; } }
    else {
#pragma unroll
        for (int j = 0; j < 16; ++j) v[j] = xr[64 * j]; }
#pragma unroll
    for (int j = 0; j < 16; ++j) s += (v[j].x * v[j].x + v[j].y * v[j].y) + (v[j].z * v[j].z + v[j].w * v[j].w);
    const float rstd = rsqrtf(wave_sum(s) * (1.f / 4096.f) + EPS);
    const GAS f32x4* gr = (const GAS f32x4*)gain + lane;
    GAS v2u* o8 = (GAS v2u*)orow + lane;
#pragma unroll
    for (int j = 0; j < 16; ++j) { const f32x4 g = gr[64 * j]; v2u w; w.x = pk2(v[j].x * rstd * g.x, v[j].y * rstd * g.y); w.y = pk2(v[j].z * rstd * g.z, v[j].w * rstd * g.w); o8[64 * j] = w; }
}
__device__ __forceinline__ void ssm_lam(const float* lam_re, const float* lam_im, const float* log_dt, int g, int p, float& lr, float& li, float& cr, float& ci) {
    const float a = lam_re[g * NP + p], b = lam_im[g * NP + p], dt = expf(log_dt[g]);
    const float ar = a * dt, th = b * dt;
    const float er = expf(ar), sn = sinf(th), cs = cosf(th);
    lr = er * cs; li = er * sn;
    const float sh = sinf(0.5f * th), nr = expm1f(ar) * cs - 2.f * sh * sh, ni = li, den = a * a + b * b;
    cr = (nr * a + ni * b) / den; ci = (ni * a - nr * b) / den;
}
__device__ __forceinline__ float log_sigmoid(float z) { return z >= 0.f ? -log1pf(expf(-z)) : z - log1pf(expf(z)); }

constexpr int XT_PITCH = 136;
template <bool FULL>
__device__ __forceinline__ void ssm_chunk(const float* U, int row0, int g, const float* lamb, const bf16* BB, const bf16* CC, const float* dskip, bf16* YS,
                                          float& xr, float& xi, LAS float* bu_l, LAS bf16* xt_l, int lane) {
    typedef float f32x2 __attribute__((ext_vector_type(2)));
    const f32x2 lam = *(const f32x2*)(lamb + (g * NP + lane) * 2);
    const float lr = lam.x, li = lam.y;
    bf16x8 bfr[8];
#pragma unroll
    for (int nb = 0; nb < 8; ++nb) bfr[nb] = *(const bf16x8*)(BB + ((size_t)(g * 8 + nb) * 64 + lane) * 8);
    bf16x8 cfr[4];
    if constexpr (FULL) {
#pragma unroll
        for (int kk = 0; kk < 4; ++kk) cfr[kk] = *(const bf16x8*)(CC + ((size_t)(g * 4 + kk) * 64 + lane) * 8);
    }
    const int t16 = lane & 15, kq = lane >> 4;
    f32x4 ua = {0.f, 0.f, 0.f, 0.f}, ub = {0.f, 0.f, 0.f, 0.f};
    if (kq < 2) { const float* up = U + (size_t)(row0 + t16) * DS + g * SG + 8 * kq; ua = *(const f32x4*)up; ub = *(const f32x4*)(up + 4); }
#pragma unroll 1
    for (int sub = 0; sub < 4; ++sub) {
        const int row = row0 + 16 * sub + t16;
        const bf16x8 a = pack8f(ua, ub);
        if (sub < 3 && kq < 2) { const float* up = U + (size_t)(row + 16) * DS + g * SG + 8 * kq; ua = *(const f32x4*)up; ub = *(const f32x4*)(up + 4); }
        f32x4 bacc[8];
#pragma unroll
        for (int nb = 0; nb < 8; ++nb) { const f32x4 z = {0.f, 0.f, 0.f, 0.f}; bacc[nb] = __builtin_amdgcn_mfma_f32_16x16x32_bf16(a, bfr[nb], z, 0, 0, 0); }
        __builtin_amdgcn_sched_barrier(0);
#pragma unroll
        for (int nb = 0; nb < 8; ++nb)
#pragma unroll
            for (int j = 0; j < 4; ++j) bu_l[(4 * kq + j) * 128 + 16 * nb + t16] = bacc[nb][j];
        LDS_WAIT(); __builtin_amdgcn_sched_barrier(0);
        LDS_WAIT(); __builtin_amdgcn_wave_barrier(); asm volatile("" ::: "memory");
        f32x2 bv[16];
#pragma unroll
        for (int t = 0; t < 16; ++t) bv[t] = *(const LAS f32x2*)(bu_l + t * 128 + 2 * lane);
        LDS_WAIT(); __builtin_amdgcn_sched_barrier(0);
        unsigned xw[16];
#pragma unroll
        for (int t = 0; t < 16; ++t) { const float nxr = fmaf(lr, xr, fmaf(-li, xi, bv[t].x)), nxi = fmaf(lr, xi, fmaf(li, xr, bv[t].y)); xr = nxr; xi = nxi;
            if constexpr (FULL) xw[t] = pk2(xr, xi); }
        if constexpr (FULL) {
            __builtin_amdgcn_sched_barrier(0);
#pragma unroll
            for (int t = 0; t < 16; ++t) *(LAS unsigned*)(xt_l + t * XT_PITCH + 2 * lane) = xw[t]; }
        if constexpr (FULL) {
            LDS_WAIT(); __builtin_amdgcn_wave_barrier(); asm volatile("" ::: "memory");
            f32x4 y = {0.f, 0.f, 0.f, 0.f};
#pragma unroll
            for (int kk = 0; kk < 4; ++kk) { const bf16x8 xb = *(const LAS bf16x8*)(xt_l + t16 * XT_PITCH + 32 * kk + 8 * kq); y = __builtin_amdgcn_mfma_f32_16x16x32_bf16(cfr[kk], xb, y, 0, 0, 0); }
            const f32x4 u4 = *(const f32x4*)(U + (size_t)row * DS + g * SG + 4 * kq), d4 = *(const f32x4*)(dskip + g * SG + 4 * kq);
            float o[4];
#pragma unroll
            for (int j = 0; j < 4; ++j) { const float v = y[j] + d4[j] * u4[j]; o[j] = v * fsig(1.5957691216057308f * (v + 0.044715f * v * v * v)); }
            v2u w; w.x = pk2(o[0], o[1]); w.y = pk2(o[2], o[3]);
#if defined(DBG_NO_YS_STORE)
            asm volatile("" :: "v"(w.x), "v"(w.y));
#else
            *(GAS v2u*)(YS + (size_t)row * DS + g * SG + 4 * kq) = w;
#endif
        }
        LDS_WAIT(); __builtin_amdgcn_wave_barrier(); asm volatile("" ::: "memory");
    }
}


struct Args { const float* in[32]; float* out; unsigned char* ws; int ph_lo, ph_hi, sub, pad; };
enum { I_XP = 0, I_XS, I_CK, I_CV, I_CLF, I_SRE, I_SIM, I_NF1, I_W1A, I_W3A, I_W2A, I_NMIX, I_WIN, I_BF, I_QN, I_KN, I_LRE, I_LIM, I_LDT, I_BRE, I_BIM, I_CRE, I_CIM, I_DSK, I_WGLU,
       I_ONA, I_ONS, I_WOUT, I_NF2, I_W1B, I_W3B, I_W2B };

__global__ void __launch_bounds__(NWAVES * 64, 2) fwd_kernel(Args args) {
    extern __shared__ __attribute__((aligned(16))) unsigned char lds_raw[];
    LAS unsigned char* lds = (LAS unsigned char*)lds_raw;
    volatile LAS unsigned* MISC = (volatile LAS unsigned*)(lds + MISC_OFF);
    const int tid = threadIdx.x, lane = tid & 63, wave = __builtin_amdgcn_readfirstlane(tid >> 6);
    const int G = gridDim.x; const int bx = blockIdx.x; const int vcu = (G % 8 == 0) ? (bx % 8) * (G / 8) + bx / 8 : bx;
    Wv W; W.lane = lane; W.wave = wave; W.gw = vcu * NWAVES + wave; W.ngw = G * NWAVES;
    unsigned char* ws = args.ws; float* out = args.out;
    unsigned* ctl = (unsigned*)(ws + WS_CTL);
    bf16* W13A = (bf16*)(ws + WS_W13A); bf16* W2A = (bf16*)(ws + WS_W2A); bf16* W13B = (bf16*)(ws + WS_W13B); bf16* W2B = (bf16*)(ws + WS_W2B);
    bf16* WINT = (bf16*)(ws + WS_WIN); bf16* WFT = (bf16*)(ws + WS_WF); bf16* WGLUT = (bf16*)(ws + WS_WGLU); bf16* WOUTT = (bf16*)(ws + WS_WOUT);
    bf16* XN = (bf16*)(ws + WS_XN); bf16* HB = (bf16*)(ws + WS_H);
    bf16* QNB = (bf16*)(ws + WS_QN); float* UU = (float*)(ws + WS_U);
    bf16* KBP = (bf16*)(ws + WS_KBP); bf16* VBP = (bf16*)(ws + WS_VBP); bf16* KBS = (bf16*)(ws + WS_KBS); bf16* VBS = (bf16*)(ws + WS_VBS);
    bf16* OB = (bf16*)(ws + WS_OB); bf16* YS = (bf16*)(ws + WS_YS); bf16* YG = (bf16*)(ws + WS_YG);
    float* NFP = (float*)(ws + WS_NFP); float* FQP = (float*)(ws + WS_FQP); float* NFS = (float*)(ws + WS_NFS); float* FQS = (float*)(ws + WS_FQS);
    float* LAMB = (float*)(ws + WS_LAMB); float* LAM64 = (float*)(ws + WS_LAM64); bf16* BB = (bf16*)(ws + WS_BB); bf16* CC = (bf16*)(ws + WS_CC);
    float* SLOC = (float*)(ws + WS_SLOC); float* XIN = (float*)(ws + WS_XIN); float* S2 = (float*)(ws + WS_S2);
    float* Y = out + O_Y;

    for (int u = tid; u < (LDS_BYTES - LDSCTL_OFF) / 4; u += NWAVES * 64) ((LAS unsigned*)(lds + LDSCTL_OFF))[u] = 0u;
    __syncthreads();
    if (tid == 0) {
#pragma unroll
        for (int i = 0; i < 32; ++i) ((LAS unsigned long long*)(lds + ARGTAB_OFF))[i] = (unsigned long long)args.in[i]; }
    __syncthreads();
#define INP(i) inp_ptr(lds, (i))
#if MK_ONE_LAUNCH
    XcdBarrier bar = xcd_barrier_post(ctl + CW_BAR, MISC + 8);
#define GRID_BAR() xcd_barrier(bar)
#else
#define GRID_BAR() do { } while (0)
#endif
    const int lo = args.ph_lo, hi = args.ph_hi, sub = args.sub;
#ifndef PHASE_MASK
#define PHASE_MASK 0xFFFFFFFFu
#endif
#define IN(k) ((((PHASE_MASK) >> (k)) & 1u) && lo <= (k) && (k) < hi)
#define BOTH(k) (IN(k) && IN((k) + 1))

    constexpr int CV_I_FF = (DM / 64) * (DFF / 32), CV_I_IN = (DM / 64) * (8192 / 32), CV_I_GLU = (DS / 64) * (DS / 32), CV_NITEMS = 4 * CV_I_FF + CV_I_IN + CV_I_GLU;
#define CONVERT_RANGE(lo_, hi_, w0_, nw_) do { LAS float* scr_ = (LAS float*)(lds + RING_OFF + wave * 16384); \
        for (int it_ = (lo_) + (w0_); it_ < (hi_); it_ += (nw_)) { int r = it_; \
            if (r < 4 * CV_I_FF) { const int which = r / CV_I_FF; r -= which * CV_I_FF; const int kb = r / (DFF / 32), nb = r % (DFF / 32), n0 = 32 * nb; \
                const float* src = INP(which == 0 ? I_W1A : (which == 1 ? I_W3A : (which == 2 ? I_W1B : I_W3B))); \
                transpose_item(src, DFF, DM, 64 * kb, n0, which < 2 ? W13A : W13B, 256 * (n0 / 128) + 128 * (which & 1) + (n0 % 128), scr_, lane); continue; } \
            r -= 4 * CV_I_FF; \
            if (r < CV_I_IN) { const int kb = r / 256, nb = r % 256, n0 = 32 * nb; \
                transpose_item(INP(I_WIN), NIN, DM, 64 * kb, n0 < 6144 ? n0 : n0 + 16, WINT, n0, scr_, lane); continue; } \
            r -= CV_I_IN; \
            { const int kb = r / (DS / 32), nb = r % (DS / 32); transpose_item(INP(I_WGLU), DS, DS, 64 * kb, 32 * nb, WGLUT, 32 * nb, scr_, lane); } } } while (0)
#define TAIL_CONVERT(nwg_, src_, N_, K_, dst_) do { const int extra_ = (nwg_) % G; if (bx >= extra_) { const float* srcp_ = (src_);     \
        LAS float* scr_ = (LAS float*)(lds + RING_OFF + wave * 16384); const int nbk_ = (N_) / 32, nit_ = ((K_) / 64) * nbk_; \
        for (int it_ = (bx - extra_) * NWAVES + wave; it_ < nit_; it_ += (G - extra_) * NWAVES) { const int kb_ = it_ / nbk_, nb_ = it_ % nbk_; \
            transpose_item(srcp_, (N_), (K_), 64 * kb_, 32 * nb_, (dst_), 32 * nb_, scr_, lane); } } } while (0)
    if (IN(0)) {
        LAS float* scr = (LAS float*)(lds + RING_OFF + wave * 16384);
#if P2_HOSTS_CONVERSION
        CONVERT_RANGE(0, 2 * CV_I_FF, W.gw, W.ngw);
#if defined(P2CONV_ONLY_W13B)
        CONVERT_RANGE(4 * CV_I_FF, CV_NITEMS, W.gw, W.ngw);
#endif
#else
        CONVERT_RANGE(0, CV_NITEMS, W.gw, W.ngw);
#endif
        for (int kq = W.gw; kq < DM / 64; kq += W.ngw) { const int k = 64 * kq + lane; const float* s = INP(I_WIN) + (size_t)k * NIN + 6144;
#pragma unroll
            for (int n4 = 0; n4 < 4; ++n4) { const f32x4 v = *(const f32x4*)(s + 4 * n4);
#pragma unroll
                for (int j = 0; j < 4; ++j) WFT[(size_t)(4 * n4 + j) * DM + k] = (bf16)(pk2(v[j], 0.f) & 0xffffu); } }
        { const int gt = W.gw * 64 + lane, ngt = W.ngw * 64;
          const float* lre = INP(I_LRE); const float* lim = INP(I_LIM); const float* ldt = INP(I_LDT);
          for (int i = gt; i < NG * NP; i += ngt) { const int g = i / NP, p = i % NP; float lr, li, cr, ci; ssm_lam(lre, lim, ldt, g, p, lr, li, cr, ci);
              LAMB[2 * i] = lr; LAMB[2 * i + 1] = li; float pr = lr, pi = li;
#pragma unroll
              for (int s = 0; s < 6; ++s) { const float t = pr * pr - pi * pi; pi = 2.f * pr * pi; pr = t; }
              LAM64[2 * i] = pr; LAM64[2 * i + 1] = pi; }
          const float* bre = INP(I_BRE); const float* bim = INP(I_BIM);
          for (int i = gt; i < NG * 8 * 64; i += ngt) { const int g = i / 512, nb = (i / 64) % 8, l = i % 64, kq = l >> 4; v4u w = {0u, 0u, 0u, 0u};
              if (kq < 2) { const int n = 16 * nb + (l & 15), p = n >> 1, ri = n & 1; float lr, li, cr, ci; ssm_lam(lre, lim, ldt, g, p, lr, li, cr, ci);
                  const float* br = bre + ((size_t)(g * NP + p)) * SG + 8 * kq; const float* bi = bim + ((size_t)(g * NP + p)) * SG + 8 * kq; float v[8];
#pragma unroll
                  for (int j = 0; j < 8; ++j) v[j] = ri == 0 ? cr * br[j] - ci * bi[j] : cr * bi[j] + ci * br[j];
                  w.x = pk2(v[0], v[1]); w.y = pk2(v[2], v[3]); w.z = pk2(v[4], v[5]); w.w = pk2(v[6], v[7]); }
              *(v4u*)(BB + (size_t)i * 8) = w; }
          const float* cre = INP(I_CRE); const float* cim = INP(I_CIM);
          for (int i = gt; i < NG * 4 * 64; i += ngt) { const int g = i / 256, kk = (i / 64) % 4, l = i % 64, c = l & 15; float v[8];
#pragma unroll
              for (int j = 0; j < 8; ++j) { const int k = 32 * kk + 8 * (l >> 4) + j, p = k >> 1; v[j] = (k & 1) == 0 ? cre[((size_t)(g * SG + c)) * NP + p] : -cim[((size_t)(g * SG + c)) * NP + p]; }
              v4u w; w.x = pk2(v[0], v[1]); w.y = pk2(v[2], v[3]); w.z = pk2(v[4], v[5]); w.w = pk2(v[6], v[7]);
              *(v4u*)(CC + (size_t)i * 8) = w; } }
        for (int u = W.gw; u < NBS * NH; u += W.ngw) { const int b = u / NH, h = u % NH; const float* src = INP(I_CLF) + ((size_t)b * PAST + 16 * lane) * NH + h; float v[16]; float sm = 0.f;
#pragma unroll
            for (int i = 0; i < 16; ++i) { sm += src[(size_t)i * NH]; v[i] = sm; }
            float incl = sm;
#pragma unroll
            for (int o = 1; o < 64; o <<= 1) { const float t = __shfl_up(incl, o); if (lane >= o) incl += t; }
            const float off = incl - sm; float* nf = NFS + (size_t)u * SKVS + 16 * lane;
#pragma unroll
            for (int i = 0; i < 16; i += 4) *(f32x4*)(nf + i) = (f32x4){v[i] + off, v[i + 1] + off, v[i + 2] + off, v[i + 3] + off} * (-11.313708498984761f);
            if (lane == 63) FQS[(size_t)u * TS] = incl; }
        for (int m = W.gw; m < MR; m += W.ngw) rms_row_4096((float*)(m < NPR ? INP(I_XP) + (size_t)m * DM : INP(I_XS) + (size_t)(m - NPR) * DM), nullptr, INP(I_NF1), XN + (size_t)m * DM, lane);
        if (BOTH(0)) GRID_BAR();
    }
    if (IN(1)) {
        pg8::Gemm g{XN, W13A, MR, 2 * DFF, DM}; pg8::StaticOrder S; S.init(MR, 2 * DFF, DM, G, bx);
        pg8::EpiSwiGLU E{HB, DFF};
        pg8::gemm_phase<pg8::EpiSwiGLU, pg8::StaticOrder, GEMM_ALIGN, GEMM_SP2>(lds + RING_OFF, g, S, E);
        TAIL_CONVERT(S.nwg, INP(I_W2A), DM, DFF, W2A);
        if (BOTH(1)) GRID_BAR();
    }
    if (IN(2)) {
#if P2_HOSTS_CONVERSION
        pg8::Gemm g{HB, W2A, MR, DM, DFF}; pg8::StaticOrder S; S.init(MR, DM, DFF, G, bx);
        pg8::EpiRes E{INP(I_XP), INP(I_XS) - (size_t)NPR * DM, NPR / 256, Y, DM, 0.5f, S2 - (size_t)NPR * DM};
        pg8::gemm_phase<pg8::EpiRes, pg8::StaticOrder, GEMM_ALIGN, GEMM_SP2>(lds + RING_OFF, g, S, E);
        { const int extra = S.nwg % G;
#if defined(P2CONV_ONLY_W13B)
          if (bx >= extra) CONVERT_RANGE(2 * CV_I_FF, 4 * CV_I_FF, (bx - extra) * NWAVES + wave, (G - extra) * NWAVES); }
#else
          if (bx >= extra) CONVERT_RANGE(2 * CV_I_FF, CV_NITEMS, (bx - extra) * NWAVES + wave, (G - extra) * NWAVES); }
#endif
#else
        pg8::Gemm g{HB, W2A, MR, DM, DFF}; pg8::SplitOrder S; S.init(MR, NPR, DM, DFF, G, bx);
        pg8::EpiRes E{INP(I_XP), INP(I_XS) - (size_t)NPR * DM, NPR / 256, Y, DM, 0.5f, S2 - (size_t)NPR * DM};
        pg8::gemm_phase<pg8::EpiRes, pg8::SplitOrder, GEMM_ALIGN, GEMM_SP2>(lds + RING_OFF, g, S, E);
#endif
        if (BOTH(2)) GRID_BAR();
    }
    if (IN(3)) {
        for (int m = W.gw; m < MR; m += W.ngw) rms_row_4096(Y + (size_t)m * DM, (!P2_HOSTS_CONVERSION && m >= NPR) ? S2 + (size_t)(m - NPR) * DM : nullptr, INP(I_NMIX), XN + (size_t)m * DM, lane);
        if (BOTH(3)) GRID_BAR();
    }
    if (IN(4)) {
        pg8::Gemm g{XN, WINT, MR, 8192, DM}; pg8::StaticOrder S; S.init(MR, 8192, DM, G, bx);
        pg8::EpiWin E{QNB, out + O_KP, out + O_VP, UU, KBP, VBP, INP(I_QN), INP(I_KN), (LAS float*)(lds + QKTAB_OFF), NPR / 256,
                       (long)O_KS - (long)O_KP - (long)NPR * DA, (long)O_VS - (long)O_VP - (long)NPR * DA};
#if defined(PROBE_NULL_EPI)
        if (sub == 1) { pg8::EpiNull EN; pg8::gemm_phase<pg8::EpiNull, pg8::StaticOrder, GEMM_ALIGN, GEMM_SP2>(lds + RING_OFF, g, S, EN); } else
        if (sub == 2) { pg8::EpiNull EN; pg8::SameOrder SS{10}; pg8::gemm_phase<pg8::EpiNull, pg8::SameOrder, GEMM_ALIGN, GEMM_SP2>(lds + RING_OFF, g, SS, EN); } else
#endif
        pg8::gemm_phase<pg8::EpiWin, pg8::StaticOrder, GEMM_ALIGN, GEMM_SP2>(lds + RING_OFF, g, S, E);
        if (BOTH(4)) GRID_BAR();
    }
    if (IN(5)) {
        if (sub & 1) { const float* bfv = INP(I_BF);
          LAS f32x4* red = (LAS f32x4*)(lds + RING_OFF);
          const int hw = wave >> 2, kq4 = wave & 3;
          for (int t0 = 2 * vcu; t0 < MR / 16; t0 += 2 * G) { const int task = t0 + hw, row0 = 16 * task; f32x4 acc = {0.f, 0.f, 0.f, 0.f};
              const bf16* ap = XN + (size_t)(row0 + (lane & 15)) * DM + 1024 * kq4 + 8 * (lane >> 4); const bf16* bp = WFT + (size_t)(lane & 15) * DM + 1024 * kq4 + 8 * (lane >> 4);
#pragma unroll 8
              for (int kk = 0; kk < 32; ++kk) acc = __builtin_amdgcn_mfma_f32_16x16x32_bf16(*(const bf16x8*)(ap + 32 * kk), *(const bf16x8*)(bp + 32 * kk), acc, 0, 0, 0);
              __builtin_amdgcn_sched_barrier(0);
              red[(hw * 4 + kq4) * 64 + lane] = acc;
              LDS_WAIT(); __builtin_amdgcn_sched_barrier(0);
              __syncthreads();
              if (kq4 == 0) { const f32x4 s4 = (red[(hw * 4 + 0) * 64 + lane] + red[(hw * 4 + 1) * 64 + lane]) + (red[(hw * 4 + 2) * 64 + lane] + red[(hw * 4 + 3) * 64 + lane]);
                  const int h = lane & 15; const float bias = bfv[h];
                  f32x4 lf4;
#pragma unroll
                  for (int j = 0; j < 4; ++j) { const int r = row0 + 4 * (lane >> 4) + j; const float lf = log_sigmoid(s4[j] + bias); lf4[j] = lf;
                      if (r < NPR) out[O_LP + (size_t)r * NH + h] = lf; else out[O_LS + (size_t)(r - NPR) * NH + h] = lf; }
                  { const int r0 = row0 + 4 * (lane >> 4); if (r0 < NPR) *(f32x4*)(FQP + ((size_t)((r0 >> 12) * NH + h)) * SEQ + (r0 & (SEQ - 1))) = lf4; } }
              __syncthreads(); } }
        if (sub & 4) { LAS float* bu_l = (LAS float*)(lds + RING_OFF + wave * 12800); LAS bf16* xt_l = (LAS bf16*)(lds + RING_OFF + wave * 12800 + 8192);
          for (int task = W.gw; task < 128 * NG; task += W.ngw) { const int sc = task / NG, g = task % NG; float xr = 0.f, xi = 0.f;
              ssm_chunk<false>(UU, (sc / 64) * SEQ + (sc % 64) * 64, g, LAMB, BB, CC, INP(I_DSK), YS, xr, xi, bu_l, xt_l, lane);
              SLOC[((size_t)task * NP + lane) * 2] = xr; SLOC[((size_t)task * NP + lane) * 2 + 1] = xi; } }
        if (BOTH(5)) GRID_BAR();
    }
    if (IN(6)) {
        constexpr float RS = 11.313708498984761f;
        for (int task = W.gw; task < NBP * NH + NBS * NH; task += W.ngw) {
            if (task < NBP * NH) {
                const float* src = FQP + (size_t)task * SEQ + lane; float* nf = NFP + (size_t)task * SEQ + lane; float v[64];
#pragma unroll
                for (int c = 0; c < 64; ++c) v[c] = src[64 * c];
                float carry = 0.f;
#pragma unroll
                for (int c = 0; c < 64; ++c) { float incl = v[c];
#pragma unroll
                    for (int o = 1; o < 64; o <<= 1) { const float t = __shfl_up(incl, o); if (lane >= o) incl += t; }
                    nf[64 * c] = (carry + incl) * (-RS); carry += __shfl(incl, 63); } }
            else { const int u = task - NBP * NH, b = u / NH, h = u % NH;
                float incl = out[O_LS + ((size_t)b * TS + lane) * NH + h];
#pragma unroll
                for (int o = 1; o < 64; o <<= 1) { const float t = __shfl_up(incl, o); if (lane >= o) incl += t; }
                NFS[(size_t)u * SKVS + PAST + lane] = (FQS[(size_t)u * TS] + incl) * (-RS); }
        }
        for (int task = W.gw; task < NBP * NG; task += W.ngw) { const int b = task / NG, g = task % NG; typedef float f32x2 __attribute__((ext_vector_type(2)));
            const f32x2 l64 = *(const f32x2*)(LAM64 + (g * NP + lane) * 2); float xr = 0.f, xi = 0.f;
#pragma unroll 8
            for (int c = 0; c < 64; ++c) { const size_t idx = (((size_t)(b * 64 + c) * NG + g) * NP + lane) * 2; *(f32x2*)(XIN + idx) = (f32x2){xr, xi}; const f32x2 s = *(const f32x2*)(SLOC + idx);
                const float nxr = fmaf(l64.x, xr, fmaf(-l64.y, xi, s.x)), nxi = fmaf(l64.x, xi, fmaf(l64.y, xr, s.y)); xr = nxr; xi = nxi; }
            out[O_SRP + (size_t)task * NP + lane] = xr; out[O_SIP + (size_t)task * NP + lane] = xi; }
        if (BOTH(6)) GRID_BAR();
    }
    if (IN(7)) {
        {
          float Dskip; { const float* gqp = INP(I_QN); const float* gkp = INP(I_KN); float mq = fmaxf(fabsf(gqp[lane]), fabsf(gqp[lane + 64])), mk = fmaxf(fabsf(gkp[lane]), fabsf(gkp[lane + 64]));
#pragma unroll
              for (int o = 1; o < 64; o <<= 1) { mq = fmaxf(mq, __shfl_xor(mq, o)); mk = fmaxf(mk, __shfl_xor(mk, o)); }
              Dskip = 256.0f * mq * mk + 110.0f * 11.313708498984761f; }
#if defined(ATTN_NO_SKIP)
          Dskip = 3.0e38f;
#endif
          auto sec_prompt = [&]() __attribute__((always_inline)) {
          if (sub & 1) { typedef att::BlockRef<att::bf16> BR; att::Seam<att::bf16> S; const att::KVBase kvb{(const char*)ws, (const char*)ws, (const char*)ws};
#define MKREF(r, L_, pass_) do { const int L__ = (L_); const int bh = L__ >> 3, x = L__ & 7, qb = (pass_) ? 15 - x : x, b = bh >> 4, h = bh & 15; const unsigned r0 = (unsigned)b * SEQ, rq = r0 + (unsigned)qb * 256; \
              (r).q = (unsigned)WS_QN + (rq * DA + h * HD) * 2u; (r).k = (unsigned)WS_KBP + (r0 * DA + h * HD) * 2u; (r).v = (unsigned)WS_VBP + (r0 * DA + h * HD) * 2u; (r).k2 = (r).k; (r).v2 = (r).v; \
              (r).nf = (unsigned)WS_NFP + (unsigned)bh * SEQ * 4u; (r).o = (unsigned)WS_OB + (rq * DA + h * HD) * 2u; (r).P0 = qb * 256; (r).skv = SEQ; (r).qrows = 256; (r).split = 1 << 30; } while (0)
            int L = bx;
            if (L < 256) { int pass = 0; BR cur; MKREF(cur, L, 0);
                att::fox_prime<att::bf16>((const char*)ws, kvb, cur, Dskip, (char*)lds_raw + RING_OFF, S);
                for (;;) { const bool more_pass = pass == 0, more_item = L + G < 256, last = !more_pass && !more_item;
                    int passn = pass + 1, Ln = L; if (!more_pass) { passn = 0; Ln = more_item ? L + G : L; }
                    BR nxt = cur; if (!last) MKREF(nxt, Ln, passn);
                    att::fox_block<att::bf16>((const char*)ws, (char*)ws, kvb, cur, nxt, Dskip, (char*)lds_raw + RING_OFF, S);
                    if (last) break;
                    cur = nxt; pass = passn; L = Ln; } }
#undef MKREF
          }
          __syncthreads(); };
          auto sec_sample = [&]() __attribute__((always_inline)) {
          if (sub & 4) { typedef att::BlockRef<float> BR; att::Seam<float> S; const att::KVBase kvb{(const char*)INP(I_CK), (const char*)INP(I_CV), (const char*)out};
#define MKREF(r, U_) do { const int u = (U_), b = u >> 4, h = u & 15; const unsigned rq = (unsigned)NPR + (unsigned)b * TS; \
              (r).q = (unsigned)WS_QN + (rq * DA + h * HD) * 2u; (r).k = ((unsigned)b * PAST * DA + h * HD) * 4u; (r).v = (r).k; \
              (r).k2 = (unsigned)((O_KS + ((size_t)b * TS) * DA + h * HD - (size_t)PAST * DA) * 4); (r).v2 = (unsigned)((O_VS + ((size_t)b * TS) * DA + h * HD - (size_t)PAST * DA) * 4); \
              (r).nf = (unsigned)WS_NFS + (unsigned)u * SKVS * 4u; (r).o = (unsigned)WS_OB + (rq * DA + h * HD) * 2u; (r).P0 = PAST; (r).skv = SKVS; (r).qrows = TS; (r).split = PAST; } while (0)
            int U = bx;
            if (U < NBS * NH) { BR cur; MKREF(cur, U);
                att::fox_prime<float>((const char*)ws, kvb, cur, Dskip, (char*)lds_raw + RING_OFF, S);
                for (;;) { const bool last = U + G >= NBS * NH;
                    BR nxt = cur; if (!last) MKREF(nxt, U + G);
                    att::fox_block<float>((const char*)ws, (char*)ws, kvb, cur, nxt, Dskip, (char*)lds_raw + RING_OFF, S);
                    if (last) break;
                    cur = nxt; U += G; } }
#undef MKREF
          }
          __syncthreads(); };
          auto sec_ssm = [&]() __attribute__((always_inline)) {
        if (sub & 2) { LAS float* bu_l = (LAS float*)(lds + RING_OFF + wave * 12800); LAS bf16* xt_l = (LAS bf16*)(lds + RING_OFF + wave * 12800 + 8192);
          for (int task = W.gw; task < (128 + NBS) * NG; task += W.ngw) { const int sc = task / NG, g = task % NG; float xr, xi; int row0;
              if (sc < 128) { row0 = (sc / 64) * SEQ + (sc % 64) * 64; xr = XIN[((size_t)task * NP + lane) * 2]; xi = XIN[((size_t)task * NP + lane) * 2 + 1]; }
              else { const int b = sc - 128; row0 = NPR + b * TS; xr = INP(I_SRE)[((size_t)b * NG + g) * NP + lane]; xi = INP(I_SIM)[((size_t)b * NG + g) * NP + lane]; }
#if defined(DBG_SSM_NOFULL)
              ssm_chunk<false>(UU, row0, g, LAMB, BB, CC, INP(I_DSK), YS, xr, xi, bu_l, xt_l, lane);
#else
              ssm_chunk<true>(UU, row0, g, LAMB, BB, CC, INP(I_DSK), YS, xr, xi, bu_l, xt_l, lane);
#endif
#if defined(DBG_NO_STATE_STORE)
              asm volatile("" :: "v"(xr), "v"(xi));
#else
              if (sc >= 128) { const int b = sc - 128; out[O_SRS + ((size_t)b * NG + g) * NP + lane] = xr; out[O_SIS + ((size_t)b * NG + g) * NP + lane] = xi; }
#endif
          } }
          __syncthreads(); };
#if P7_ROTATE == 3
          const int rot = bx % 3;
          if (rot == 2) sec_ssm();
          if (rot != 1) sec_prompt();
          sec_sample();
          if (rot != 2) sec_ssm();
          if (rot == 1) sec_prompt();
#elif P7_ROTATE == 2
          const int rot = bx & 1;
          if (rot == 0) sec_sample();
          sec_prompt(); sec_ssm();
          if (rot == 1) sec_sample();
#else
          sec_prompt(); sec_sample(); sec_ssm();
#endif
        }
        if (BOTH(7)) GRID_BAR();
    }
    auto merge_half = [&](int row, int half) __attribute__((always_inline)) {
            const bf16* src = (half ? YG : OB) + (size_t)row * DA; const float* gain = INP(half ? I_ONS : I_ONA); bf16* dst = XN + (size_t)row * DM + half * DA;
            v4u v[4]; float s = 0.f;
#pragma unroll
            for (int j = 0; j < 4; ++j) { v[j] = *(const v4u*)(src + 8 * (lane + 64 * j));
                const float a0 = bf_lo(v[j].x), a1 = bf_hi(v[j].x), a2 = bf_lo(v[j].y), a3 = bf_hi(v[j].y), a4 = bf_lo(v[j].z), a5 = bf_hi(v[j].z), a6 = bf_lo(v[j].w), a7 = bf_hi(v[j].w);
                s += ((a0 * a0 + a1 * a1) + (a2 * a2 + a3 * a3)) + ((a4 * a4 + a5 * a5) + (a6 * a6 + a7 * a7)); }
            const float r = rsqrtf(wave_sum(s) * (1.f / 2048.f) + EPS);
#pragma unroll
            for (int j = 0; j < 4; ++j) { const f32x4 g0 = *(const f32x4*)(gain + 8 * (lane + 64 * j)), g1 = *(const f32x4*)(gain + 8 * (lane + 64 * j) + 4); v4u w;
                w.x = pk2(bf_lo(v[j].x) * r * g0.x, bf_hi(v[j].x) * r * g0.y); w.y = pk2(bf_lo(v[j].y) * r * g0.z, bf_hi(v[j].y) * r * g0.w);
                w.z = pk2(bf_lo(v[j].z) * r * g1.x, bf_hi(v[j].z) * r * g1.y); w.w = pk2(bf_lo(v[j].w) * r * g1.z, bf_hi(v[j].w) * r * g1.w);
                *(v4u*)(dst + 8 * (lane + 64 * j)) = w; } };
    if (IN(8)) {
        pg8::Gemm g{YS, WGLUT, MR, DS, DS}; pg8::StaticOrder S; S.init(MR, DS, DS, G, bx);
        pg8::EpiGLU E{YS, YG, DS};
        pg8::gemm_phase<pg8::EpiGLU, pg8::StaticOrder, GEMM_ALIGN, GEMM_SP2>(lds + RING_OFF, g, S, E);
        TAIL_CONVERT(S.nwg, INP(I_WOUT), DM, DM, WOUTT);
#if P8_HOSTS_OB_NORM
        { const int extra = S.nwg % G; if (bx >= extra) for (int row = (bx - extra) * NWAVES + wave; row < MR; row += (G - extra) * NWAVES) merge_half(row, 0); }
#endif
        if (BOTH(8)) GRID_BAR();
    }
    if (IN(9)) {
#if P8_HOSTS_OB_NORM
        for (int row = W.gw; row < MR; row += W.ngw) merge_half(row, 1);
#else
        for (int task = W.gw; task < 2 * MR; task += W.ngw) merge_half(task >> 1, task & 1);
#endif
        if (BOTH(9)) GRID_BAR();
    }
    if (IN(10)) {
        pg8::Gemm g{XN, WOUTT, MR, DM, DM}; pg8::SplitOrder S; S.init(MR, NPR, DM, DM, G, bx);
        pg8::EpiRes E{Y, Y, 1 << 30, Y, DM, 1.0f, S2 - (size_t)NPR * DM};
        pg8::gemm_phase<pg8::EpiRes, pg8::SplitOrder, GEMM_ALIGN, GEMM_SP2>(lds + RING_OFF, g, S, E);
        if (BOTH(10)) GRID_BAR();
    }
    if (IN(11)) {
        for (int m = W.gw; m < MR; m += W.ngw) rms_row_4096(Y + (size_t)m * DM, m >= NPR ? S2 + (size_t)(m - NPR) * DM : nullptr, INP(I_NF2), XN + (size_t)m * DM, lane);
        if (BOTH(11)) GRID_BAR();
    }
    if (IN(12)) {
        pg8::Gemm g{XN, W13B, MR, 2 * DFF, DM}; pg8::StaticOrder S; S.init(MR, 2 * DFF, DM, G, bx);
        pg8::EpiSwiGLU E{HB, DFF};
        pg8::gemm_phase<pg8::EpiSwiGLU, pg8::StaticOrder, GEMM_ALIGN, GEMM_SP2>(lds + RING_OFF, g, S, E);
        TAIL_CONVERT(S.nwg, INP(I_W2B), DM, DFF, W2B);
        if (BOTH(12)) GRID_BAR();
    }
    if (IN(13)) {
        pg8::Gemm g{HB, W2B, MR, DM, DFF}; pg8::SplitOrder S; S.init(MR, NPR, DM, DFF, G, bx);
        pg8::EpiRes E{Y, Y, 1 << 30, Y, DM, 0.5f, S2 - (size_t)NPR * DM};
        pg8::gemm_phase<pg8::EpiRes, pg8::SplitOrder, GEMM_ALIGN, GEMM_SP2>(lds + RING_OFF, g, S, E);
        if (BOTH(13)) GRID_BAR();
    }
    if (IN(14)) {
        for (size_t i = (size_t)W.gw * 64 + lane; i < (size_t)NSR * DM / 4; i += (size_t)W.ngw * 64) { GAS f32x4* yp = (GAS f32x4*)(Y + (size_t)NPR * DM) + i; *yp = *yp + ((const GAS f32x4*)S2)[i]; }
    }
#undef IN
#undef BOTH
}

#if defined(DBG_STOP_AFTER)
__global__ void dbg_fill(float* out) { for (size_t i = (size_t)blockIdx.x * blockDim.x + threadIdx.x; i < O_END / 4; i += (size_t)gridDim.x * blockDim.x) ((f32x4*)out)[i] = (f32x4){0.f, 0.f, 0.f, 0.f}; }
#endif
extern "C" void kernel_launch(void* const* d_in, const int* in_sizes, int n_in, void* d_out, int out_size, void* d_ws, size_t ws_size, hipStream_t stream) {
    static int grid = 0;
    if (grid == 0) {
        if (n_in != 32 || out_size != (int)O_END || ws_size < WS_END) { fprintf(stderr, "kernel_launch: unexpected problem (n_in %d, out %d, ws %zu; want 32, %zu, >= %zu); nothing launched\n", n_in, out_size, ws_size, (size_t)O_END, (size_t)WS_END); grid = -1; return; }
        int dev = 0, cus = 0, per_cu = 0;
        if (hipGetDevice(&dev) != hipSuccess || hipDeviceGetAttribute(&cus, hipDeviceAttributeMultiprocessorCount, dev) != hipSuccess) { fprintf(stderr, "kernel_launch: device query failed\n"); grid = -1; return; }
        if (hipFuncSetAttribute((const void*)fwd_kernel, hipFuncAttributeMaxDynamicSharedMemorySize, LDS_BYTES) != hipSuccess) { fprintf(stderr, "kernel_launch: hipFuncSetAttribute failed\n"); grid = -1; return; }
        if (hipOccupancyMaxActiveBlocksPerMultiprocessor(&per_cu, (const void*)fwd_kernel, NWAVES * 64, LDS_BYTES) != hipSuccess || per_cu < 1) { fprintf(stderr, "kernel_launch: occupancy query says %d blocks per CU\n", per_cu); }
        (void)hipGetLastError();
        grid = cus;
    }
    if (grid < 0) return;
    (void)hipMemsetAsync((char*)d_ws + WS_CTL, 0, CTL_ZERO_BYTES, stream);
    Args a{};
    for (int i = 0; i < 32; ++i) a.in[i] = (const float*)d_in[i];
    a.out = (float*)d_out; a.ws = (unsigned char*)d_ws; a.sub = 7;
#if MK_ONE_LAUNCH
    a.ph_lo = 0; a.ph_hi = N_PHASES;
    hipLaunchKernelGGL(fwd_kernel, dim3(grid), dim3(NWAVES * 64), LDS_BYTES, stream, a);
#else
#if defined(DBG_STOP_AFTER)
    hipLaunchKernelGGL(dbg_fill, dim3(1024), dim3(256), 0, stream, (float*)d_out);
#define DBG_LAST (DBG_STOP_AFTER)
#else
#define DBG_LAST (N_PHASES - 1)
#endif
#ifndef REP_MASK
#define REP_MASK 0u
#endif
#ifndef REP_SUB
#define REP_SUB 7
#endif
    for (int p = 0; p <= DBG_LAST; ++p) { a.ph_lo = p; a.ph_hi = p + 1;
        for (int r = 0; r < 1 + (int)(((unsigned)(REP_MASK) >> p) & 1u); ++r) { a.sub = r == 0 ? 7 : REP_SUB; hipLaunchKernelGGL(fwd_kernel, dim3(grid), dim3(NWAVES * 64), LDS_BYTES, stream, a); } }
#endif
    const hipError_t le = hipPeekAtLastError();
    if (le != hipSuccess) fprintf(stderr, "kernel_launch: launch failed: %s\n", hipGetErrorName(le));
}
```

```cpp
#include <hip/hip_runtime.h>
#include <cstdio>
#include <cstdint>
namespace pg8 {
#define PG8_LAS __attribute__((address_space(3)))
typedef unsigned short bf16_t;
typedef short bf16x8 __attribute__((ext_vector_type(8)));
typedef float f32x4 __attribute__((ext_vector_type(4)));
typedef unsigned u32x4 __attribute__((ext_vector_type(4)));
constexpr int BM = 256, BK = 64, HALF = 128, HTB = HALF * BK * 2  , STAGE_BYTES = 8 * HTB, NXCD = 8;

__host__ __device__ __forceinline__ int lds_byte(int r, int c) { const int st = (r >> 4) * 2 + (c >> 5), rr = r & 15, cc = c & 31, ob = rr * 64 + cc * 2; return st * 1024 + (ob ^ (((ob >> 9) & 1) << 5)); }
__host__ __device__ __forceinline__ void stage_rc(int b, int& R, int& C) { const int st = b / 1024, sb = b % 1024, swz = sb ^ (((sb >> 9) & 1) << 5); R = (st >> 1) * 16 + swz / 64; C = (st & 1) * 32 + (swz % 64) / 2; }
__host__ __device__ __forceinline__ int perm32(int rho) { const int n = rho >> 4, i = rho & 15; return 8 * (i >> 2) + 4 * n + (i & 3); }

struct Unit { int pm, pn, kt0, nkt, part; };
struct Gemm { const bf16_t* A; const bf16_t* Bt; int M, N, K; };

struct StaticOrder {
    int nM, nN, nwg, G, c, nt, WGM, pshuf = 0;
    __host__ __device__ void init(int M, int N, int K, int G_, int c_) { nM = M / BM; nN = N / BM; nwg = nM * nN; G = G_; c = c_; nt = K / BK; WGM = (nM % NXCD == 0) ? nM / NXCD : 8; }
    __host__ __device__ __forceinline__ bool next(int i, Unit& u) const {
        const long L = (long)i * G + c; const bool ok = L < nwg;
        int wgid = ok ? (int)L : 0; { const int q = nwg / NXCD, r = nwg % NXCD, xcd = wgid % NXCD, off = wgid / NXCD; wgid = (xcd < r ? xcd * (q + 1) : r * (q + 1) + (xcd - r) * q) + off; }
        const int nig = WGM * nN, gid = wgid / nig, fm = gid * WGM, gsz = (nM - fm) < WGM ? (nM - fm) : WGM;
        const int pn0 = (wgid % nig) / gsz;
        u.pm = fm + ((wgid % nig) % gsz); u.pn = pshuf ? (pn0 & 3) * (nN >> 2) + (pn0 >> 2) : pn0; u.kt0 = 0; u.nkt = nt; u.part = 0; return ok;
    }
    __device__ __forceinline__ void a_ready(const Unit&) const {}
    __device__ __forceinline__ void done(const Unit&) const {}
};
struct SameOrder { int n;
    __host__ __device__ __forceinline__ bool next(int i, Unit& u) const { u.pm = 0; u.pn = 0; u.kt0 = 0; u.nkt = 32; u.part = 0; return i < n; }
    __device__ __forceinline__ void a_ready(const Unit&) const {}
    __device__ __forceinline__ void done(const Unit&) const {}
};
struct SplitOrder {
    StaticOrder so; int nfull, pm0, nN, rem, nt, c;
    __host__ __device__ void init(int M, int Mfull, int N, int K, int G, int c_) { so.init(Mfull, N, K, G, c_); nfull = so.nwg / G; pm0 = Mfull / BM; nN = N / BM; rem = ((M - Mfull) / BM) * nN; nt = K / BK; c = c_; }
    __host__ __device__ __forceinline__ bool next(int i, Unit& u) const {
        const bool full = i < nfull, split = i == nfull && rem > 0;
        Unit a; const bool oka = so.next(full ? i : 0, a);
        const int remc = rem > 0 ? rem : 1, ns = so.G / remc, prows = remc / nN > 0 ? remc / nN : 1, nk = nt / ns;
        int j = c % remc, part = c / remc;
#if !defined(SPLIT_PLAIN)
        { const int cpx = nN * ns / NXCD; if (NXCD % ns == 0 && cpx * NXCD == nN * ns && prows * cpx * NXCD == so.G) { const int xcd = c % NXCD, m = c / NXCD; part = xcd % ns; j = ((xcd / ns) * cpx + m / prows) * prows + m % prows; } }
#endif
        u.pm = full ? a.pm : pm0 + j % prows; u.pn = full ? a.pn : j / prows; u.part = full ? 0 : part; u.nkt = full ? nt : nk; u.kt0 = full ? 0 : part * nk;
        return full ? oka : split;
    }
    __device__ __forceinline__ void a_ready(const Unit&) const {}
    __device__ __forceinline__ void done(const Unit&) const {}
};

__device__ __forceinline__ unsigned cvt_pk_bf16(float lo, float hi) { unsigned r; asm volatile("v_cvt_pk_bf16_f32 %0, %1, %2" : "=v"(r) : "v"(lo), "v"(hi)); return r; }
typedef float f32x2 __attribute__((ext_vector_type(2)));

typedef unsigned u32x2 __attribute__((ext_vector_type(2)));
__device__ __forceinline__ float fast_sigmoid(float x) { return __builtin_amdgcn_rcpf(1.0f + __builtin_amdgcn_exp2f(-1.4426950408889634f * x)); }
typedef float f32x2v __attribute__((ext_vector_type(2)));
__device__ __forceinline__ f32x2v swiglu2(f32x2v g, f32x2v u) { const f32x2v t = g * (f32x2v){-1.4426950408889634f, -1.4426950408889634f};
    const f32x2v d = (f32x2v){__builtin_amdgcn_exp2f(t.x), __builtin_amdgcn_exp2f(t.y)} + (f32x2v){1.0f, 1.0f};
    return (g * u) * (f32x2v){__builtin_amdgcn_rcpf(d.x), __builtin_amdgcn_rcpf(d.y)}; }
struct EpiSwiGLU {
    static constexpr bool PERM = true, AFTER_DRAIN = false;
    bf16_t* Hh; int ldh;
    __device__ __forceinline__ void operator()(const f32x4 (&acc)[2][2][4][2], const Unit& u, int wr, int wc, int fr, int fq) const {
        const int row0 = u.pm * BM + wr * 64 + fr, col0 = u.pn * HALF + wc * 32 + 8 * fq;
#pragma unroll
        for (int ai = 0; ai < 2; ++ai)
#pragma unroll
            for (int m = 0; m < 4; ++m) { bf16_t* rowp = Hh + (size_t)(row0 + ai * HALF + m * 16) * ldh + col0;
                const f32x4 g0 = acc[ai][0][m][0], g1 = acc[ai][0][m][1], u0 = acc[ai][1][m][0], u1 = acc[ai][1][m][1];
                const f32x2v p0 = swiglu2((f32x2v){g0[0], g0[1]}, (f32x2v){u0[0], u0[1]}), p1 = swiglu2((f32x2v){g0[2], g0[3]}, (f32x2v){u0[2], u0[3]}),
                             p2 = swiglu2((f32x2v){g1[0], g1[1]}, (f32x2v){u1[0], u1[1]}), p3 = swiglu2((f32x2v){g1[2], g1[3]}, (f32x2v){u1[2], u1[3]});
                u32x4 w; w.x = cvt_pk_bf16(p0.x, p0.y); w.y = cvt_pk_bf16(p1.x, p1.y); w.z = cvt_pk_bf16(p2.x, p2.y); w.w = cvt_pk_bf16(p3.x, p3.y);
                *(u32x4*)rowp = w; }
    }
};
struct EpiRes {
    static constexpr bool PERM = false, AFTER_DRAIN = false;
    const float* base; const float* base2; int pm_split; float* out; int ldc; float s; float* part_out;
    __device__ __forceinline__ void operator()(const f32x4 (&acc)[2][2][4][2], const Unit& u, int wr, int wc, int fr, int fq) const {
        const int row0 = u.pm * BM + wr * 64 + fr, col0 = u.pn * BM + wc * 32 + 4 * fq;
        if (u.part != 0) {
#pragma unroll
            for (int ai = 0; ai < 2; ++ai)
#pragma unroll
                for (int m = 0; m < 4; ++m) { float* rowp = part_out + (size_t)(row0 + ai * HALF + m * 16) * ldc + col0;
#pragma unroll
                    for (int bj = 0; bj < 2; ++bj)
#pragma unroll
                        for (int n = 0; n < 2; ++n) *(f32x4*)(rowp + bj * HALF + n * 16) = acc[ai][bj][m][n] * s; }
            return; }
        const float* bs = u.pm >= pm_split ? base2 : base;
#pragma unroll
        for (int ai = 0; ai < 2; ++ai) { f32x4 b[4][2][2];
#pragma unroll
            for (int m = 0; m < 4; ++m) { const size_t off = (size_t)(row0 + ai * HALF + m * 16) * ldc + col0;
#pragma unroll
                for (int bj = 0; bj < 2; ++bj)
#pragma unroll
                    for (int n = 0; n < 2; ++n) b[m][bj][n] = *(const f32x4*)(bs + off + bj * HALF + n * 16); }
            asm volatile("" ::: "memory");
#pragma unroll
            for (int m = 0; m < 4; ++m) { const size_t off = (size_t)(row0 + ai * HALF + m * 16) * ldc + col0;
#pragma unroll
                for (int bj = 0; bj < 2; ++bj)
#pragma unroll
                    for (int n = 0; n < 2; ++n) *(f32x4*)(out + off + bj * HALF + n * 16) = b[m][bj][n] + acc[ai][bj][m][n] * s; }
            asm volatile("" ::: "memory"); }
    }
};
struct EpiWin {
    static constexpr bool PERM = false, AFTER_DRAIN = false;
    bf16_t* qnb; float* kp; float* vp; float* uu; bf16_t* kbp; bf16_t* vbp; const float* gq; const float* gk; PG8_LAS float* tab; int pm_split;
    long dks, dvs;
    __device__ __forceinline__ void operator()(const f32x4 (&acc)[2][2][4][2], const Unit& u, int wr, int wc, int fr, int fq) const {
        const int seg = u.pn >> 3; const bool smp = u.pm >= pm_split;
        const int row0 = u.pm * BM + wr * 64 + fr, col0 = (u.pn & 7) * BM + wc * 32 + 4 * fq;
        if (seg >= 2) {
            float* dst = seg == 2 ? vp + (smp ? dvs : 0l) : uu;
#pragma unroll
            for (int ai = 0; ai < 2; ++ai)
#pragma unroll
                for (int m = 0; m < 4; ++m) { const int row = row0 + ai * HALF + m * 16; float* rowp = dst + (size_t)row * 2048 + col0;
#pragma unroll
                    for (int bj = 0; bj < 2; ++bj)
#pragma unroll
                        for (int n = 0; n < 2; ++n) *(f32x4*)(rowp + bj * HALF + n * 16) = acc[ai][bj][m][n];
                    if (seg == 2 && !smp) { bf16_t* bp = vbp + (size_t)row * 2048 + col0;
#pragma unroll
                        for (int bj = 0; bj < 2; ++bj)
#pragma unroll
                            for (int n = 0; n < 2; ++n) { const f32x4 a = acc[ai][bj][m][n]; u32x2 w; w.x = cvt_pk_bf16(a[0], a[1]); w.y = cvt_pk_bf16(a[2], a[3]); *(u32x2*)(bp + bj * HALF + n * 16) = w; } } }
            return; }
        const int rl0 = wr * 64 + fr;
#pragma unroll
        for (int ai = 0; ai < 2; ++ai)
#pragma unroll
            for (int m = 0; m < 4; ++m)
#pragma unroll
                for (int bj = 0; bj < 2; ++bj) { const f32x4 a = acc[ai][bj][m][0], b = acc[ai][bj][m][1];
                    float ss = ((a[0] * a[0] + a[1] * a[1]) + (a[2] * a[2] + a[3] * a[3])) + ((b[0] * b[0] + b[1] * b[1]) + (b[2] * b[2] + b[3] * b[3]));
                    ss += __shfl_xor(ss, 16); ss += __shfl_xor(ss, 32);
                    if (fq == 0) tab[((rl0 + ai * HALF + m * 16) * 2 + bj) * 4 + wc] = ss; }
        asm volatile("s_waitcnt lgkmcnt(0)" ::: "memory"); __builtin_amdgcn_s_barrier(); asm volatile("" ::: "memory");
        const f32x4 g0q = *(const f32x4*)(gq + wc * 32 + 4 * fq), g1q = *(const f32x4*)(gq + wc * 32 + 16 + 4 * fq), g0k = *(const f32x4*)(gk + wc * 32 + 4 * fq), g1k = *(const f32x4*)(gk + wc * 32 + 16 + 4 * fq);
        const f32x4 g0 = seg == 0 ? g0q : g0k, g1 = seg == 0 ? g1q : g1k;
#pragma unroll
        for (int ai = 0; ai < 2; ++ai)
#pragma unroll
            for (int m = 0; m < 4; ++m) { const int row = row0 + ai * HALF + m * 16;
#pragma unroll
                for (int bj = 0; bj < 2; ++bj) { const f32x4 t = *(const PG8_LAS f32x4*)(tab + ((rl0 + ai * HALF + m * 16) * 2 + bj) * 4);
                    const float r = __builtin_amdgcn_rsqf(((t[0] + t[1]) + (t[2] + t[3])) * (1.0f / 128.0f) + 1e-6f);
                    const f32x4 o0 = acc[ai][bj][m][0] * r * g0, o1 = acc[ai][bj][m][1] * r * g1;
                    u32x2 w0, w1; w0.x = cvt_pk_bf16(o0[0], o0[1]); w0.y = cvt_pk_bf16(o0[2], o0[3]); w1.x = cvt_pk_bf16(o1[0], o1[1]); w1.y = cvt_pk_bf16(o1[2], o1[3]);
                    if (seg == 0) { bf16_t* qp = qnb + (size_t)row * 2048 + col0 + bj * HALF; *(u32x2*)qp = w0; *(u32x2*)(qp + 16) = w1; }
                    else { float* kf = kp + (smp ? dks : 0l) + (size_t)row * 2048 + col0 + bj * HALF; *(f32x4*)kf = o0; *(f32x4*)(kf + 16) = o1;
                           if (!smp) { bf16_t* kb = kbp + (size_t)row * 2048 + col0 + bj * HALF; *(u32x2*)kb = w0; *(u32x2*)(kb + 16) = w1; } } } }
    }
};
struct EpiNull {
    static constexpr bool PERM = false, AFTER_DRAIN = false;
    __device__ __forceinline__ void operator()(const f32x4 (&acc)[2][2][4][2], const Unit& u, int wr, int wc, int fr, int fq) const {
#pragma unroll
        for (int ai = 0; ai < 2; ++ai)
#pragma unroll
            for (int bj = 0; bj < 2; ++bj)
#pragma unroll
                for (int m = 0; m < 4; ++m)
#pragma unroll
                    for (int n = 0; n < 2; ++n) asm volatile("" :: "v"(acc[ai][bj][m][n]));
    }
};
struct EpiGLU {
    static constexpr bool PERM = true, AFTER_DRAIN = false;
    const bf16_t* Y; bf16_t* O; int ldc;
    __device__ __forceinline__ void operator()(const f32x4 (&acc)[2][2][4][2], const Unit& u, int wr, int wc, int fr, int fq) const {
        const int row0 = u.pm * BM + wr * 64 + fr, col0 = u.pn * BM + wc * 32 + 8 * fq;
#pragma unroll
        for (int ai = 0; ai < 2; ++ai) { u32x4 yb[4][2];
#pragma unroll
            for (int m = 0; m < 4; ++m)
#pragma unroll
                for (int bj = 0; bj < 2; ++bj) yb[m][bj] = *(const u32x4*)(Y + (size_t)(row0 + ai * HALF + m * 16) * ldc + col0 + bj * HALF);
            asm volatile("" ::: "memory");
#pragma unroll
            for (int m = 0; m < 4; ++m) { const size_t off = (size_t)(row0 + ai * HALF + m * 16) * ldc + col0;
#pragma unroll
                for (int bj = 0; bj < 2; ++bj) { const u32x4 yv = yb[m][bj]; const f32x4 a0 = acc[ai][bj][m][0], a1 = acc[ai][bj][m][1];
                    float y[8]; y[0] = __uint_as_float(yv.x << 16); y[1] = __uint_as_float(yv.x & 0xffff0000u); y[2] = __uint_as_float(yv.y << 16); y[3] = __uint_as_float(yv.y & 0xffff0000u);
                    y[4] = __uint_as_float(yv.z << 16); y[5] = __uint_as_float(yv.z & 0xffff0000u); y[6] = __uint_as_float(yv.w << 16); y[7] = __uint_as_float(yv.w & 0xffff0000u);
                    float o[8];
#pragma unroll
                    for (int j = 0; j < 4; ++j) { o[j] = y[j] * fast_sigmoid(a0[j]); o[4 + j] = y[4 + j] * fast_sigmoid(a1[j]); }
                    u32x4 w; w.x = cvt_pk_bf16(o[0], o[1]); w.y = cvt_pk_bf16(o[2], o[3]); w.z = cvt_pk_bf16(o[4], o[5]); w.w = cvt_pk_bf16(o[6], o[7]);
                    *(u32x4*)(O + off + bj * HALF) = w; } } }
    }
};

template <class Epi, class Sched, bool ALIGN_EPI = false, bool SP2 = false>
__device__ __forceinline__ void gemm_phase(PG8_LAS unsigned char* lds, const Gemm g, const Sched& S, const Epi& E) {
    const int tid = threadIdx.x, wid = __builtin_amdgcn_readfirstlane(tid >> 6), lane = tid & 63, wr = wid >> 2, wc = wid & 3, fr = lane & 15, fq = lane >> 4;
    const int K = g.K;
    unsigned voffA[2], voffB[2];
#pragma unroll
    for (int i = 0; i < 2; ++i) { int R, C; stage_rc(tid * 16 + i * 8192, R, C); const int Rb = Epi::PERM ? ((R & ~31) + perm32(R & 31)) : R;
        voffA[i] = (unsigned)(R * K + C) * 2u; voffB[i] = (unsigned)(Rb * K + C) * 2u; }
    const size_t kstep = (size_t)(BK * 2);
    const size_t hstep = (size_t)HALF * K * 2;
    const size_t tstep = 2 * hstep;
    const unsigned ldsw = (unsigned)wid * 1024u;
    const int aoff = lds_byte(wr * 64 + fr, fq * 8), boff = lds_byte(wc * 32 + fr, fq * 8);
#define PG8_SA(b, h) (((b) * 2 + (h)) * HTB)
#define PG8_SB(b, h) ((4 + (b) * 2 + (h)) * HTB)
#define PG8_STAGE(bufoff, gbase, voff) do { _Pragma("unroll") for (int _i = 0; _i < 2; ++_i) \
        __builtin_amdgcn_global_load_lds((const unsigned*)((const char*)(gbase) + (voff)[_i]), (PG8_LAS unsigned*)(lds + (bufoff) + ldsw + _i * 8192), 16, 0, 0); } while (0)
#define PG8_LDA(dst, b, h) do { _Pragma("unroll") for (int m = 0; m < 4; ++m) _Pragma("unroll") for (int k = 0; k < 2; ++k) dst[m][k] = *(const PG8_LAS bf16x8*)(lds + PG8_SA(b, h) + aoff + m * 2048 + k * 1024); } while (0)
#define PG8_LDB(dst, b, h) do { _Pragma("unroll") for (int n = 0; n < 2; ++n) _Pragma("unroll") for (int k = 0; k < 2; ++k) dst[n][k] = *(const PG8_LAS bf16x8*)(lds + PG8_SB(b, h) + boff + n * 2048 + k * 1024); } while (0)
#define PG8_MMA(ai, bj, At, Bt) do { __builtin_amdgcn_s_setprio(1); _Pragma("unroll") for (int m = 0; m < 4; ++m) _Pragma("unroll") for (int n = 0; n < 2; ++n) _Pragma("unroll") for (int k = 0; k < 2; ++k) \
        acc[ai][bj][m][n] = __builtin_amdgcn_mfma_f32_16x16x32_bf16(Bt[n][k], At[m][k], acc[ai][bj][m][n], 0, 0, 0); __builtin_amdgcn_s_setprio(0); } while (0)
#define PG8_WAIT_V(n) asm volatile("s_waitcnt vmcnt(" #n ")" ::: "memory")
#define PG8_WAIT_L(n) asm volatile("s_waitcnt lgkmcnt(" #n ")" ::: "memory")
#define PG8_BAR __builtin_amdgcn_s_barrier()
#define PG8_SCHED __builtin_amdgcn_sched_barrier(0)
    Unit cur, nxt; int ui = 0;
    if (!S.next(0, cur)) return;
    f32x4 acc[2][2][4][2];
#pragma unroll
    for (int a = 0; a < 2; ++a)
#pragma unroll
        for (int b = 0; b < 2; ++b)
#pragma unroll
            for (int m = 0; m < 4; ++m)
#pragma unroll
                for (int n = 0; n < 2; ++n) acc[a][b][m][n] = (f32x4){0.f, 0.f, 0.f, 0.f};
    bf16x8 At[4][2], B0[2][2], B1[2][2];
    const char* cA = (const char*)g.A + (size_t)cur.pm * tstep + (size_t)cur.kt0 * kstep; const char* cB = (const char*)g.Bt + (size_t)cur.pn * tstep + (size_t)cur.kt0 * kstep;
    S.a_ready(cur);
    if constexpr (SP2) {
        PG8_STAGE(PG8_SB(0, 0), cB, voffB); PG8_STAGE(PG8_SB(0, 1), cB + hstep, voffB); PG8_STAGE(PG8_SA(0, 0), cA, voffA); PG8_STAGE(PG8_SA(0, 1), cA + hstep, voffA);
        if (wr == 1) PG8_BAR;
        PG8_WAIT_V(2); PG8_BAR;
        PG8_STAGE(PG8_SB(1, 0), cB + kstep, voffB); PG8_STAGE(PG8_SA(1, 0), cA + kstep, voffA); PG8_STAGE(PG8_SB(1, 1), cB + hstep + kstep, voffB);
        PG8_WAIT_V(6); PG8_BAR;
    } else {
        PG8_STAGE(PG8_SB(0, 0), cB, voffB); PG8_STAGE(PG8_SA(0, 0), cA, voffA); PG8_STAGE(PG8_SB(0, 1), cB + hstep, voffB); PG8_STAGE(PG8_SA(0, 1), cA + hstep, voffA);
        if (wr == 1) PG8_BAR;
        PG8_WAIT_V(4); PG8_BAR;
        PG8_STAGE(PG8_SB(1, 0), cB + kstep, voffB); PG8_STAGE(PG8_SA(1, 0), cA + kstep, voffA); PG8_STAGE(PG8_SB(1, 1), cB + hstep + kstep, voffB);
        PG8_WAIT_V(6); PG8_BAR;
    }
    for (;;) {
        const bool has_next = S.next(ui + 1, nxt);
        const char* nA = has_next ? (const char*)g.A + (size_t)nxt.pm * tstep + (size_t)nxt.kt0 * kstep : cA; const char* nB = has_next ? (const char*)g.Bt + (size_t)nxt.pn * tstep + (size_t)nxt.kt0 * kstep : cB;
        const int nt = cur.nkt;
        for (int t = 0; t < nt; t += 2) {
            const bool last = (t == nt - 2);
            const char* a1 = cA + (size_t)(t + 1) * kstep;
            const char* a2 = last ? nA : cA + (size_t)(t + 2) * kstep; const char* b2 = last ? nB : cB + (size_t)(t + 2) * kstep;
            const char* a3 = a2 + kstep; const char* b3 = b2 + kstep;
            if (last && has_next) S.a_ready(nxt);
            if constexpr (SP2) {
            PG8_LDB(B0, 0, 0); PG8_LDB(B1, 0, 1); PG8_SCHED; PG8_LDA(At, 0, 0); PG8_STAGE(PG8_SA(1, 1), a1 + hstep, voffA);
            PG8_WAIT_V(8); PG8_WAIT_L(0); PG8_BAR; PG8_MMA(0, 0, At, B0); PG8_MMA(0, 1, At, B1); PG8_BAR; PG8_SCHED;
            PG8_LDA(At, 0, 1); PG8_STAGE(PG8_SB(0, 0), b2, voffB); PG8_STAGE(PG8_SB(0, 1), b2 + hstep, voffB); PG8_STAGE(PG8_SA(0, 0), a2, voffA);
            PG8_WAIT_V(8); PG8_WAIT_L(0); PG8_BAR; PG8_MMA(1, 0, At, B0); PG8_MMA(1, 1, At, B1); PG8_BAR; PG8_SCHED;
            PG8_LDB(B0, 1, 0); PG8_LDB(B1, 1, 1); PG8_SCHED; PG8_LDA(At, 1, 0); PG8_STAGE(PG8_SA(0, 1), a2 + hstep, voffA);
            PG8_WAIT_V(8); PG8_WAIT_L(0); PG8_BAR; PG8_MMA(0, 0, At, B0); PG8_MMA(0, 1, At, B1); PG8_BAR; PG8_SCHED;
            PG8_LDA(At, 1, 1); PG8_STAGE(PG8_SB(1, 0), b3, voffB); PG8_STAGE(PG8_SB(1, 1), b3 + hstep, voffB); PG8_STAGE(PG8_SA(1, 0), a3, voffA);
            PG8_WAIT_V(8); PG8_WAIT_L(0); PG8_BAR; PG8_MMA(1, 0, At, B0); PG8_MMA(1, 1, At, B1); PG8_BAR; PG8_SCHED;
            } else {
            PG8_LDB(B0, 0, 0); PG8_SCHED; PG8_LDA(At, 0, 0); PG8_STAGE(PG8_SA(1, 1), a1 + hstep, voffA);
            PG8_WAIT_L(8); PG8_BAR; PG8_WAIT_L(0); PG8_MMA(0, 0, At, B0); PG8_BAR; PG8_SCHED;
            PG8_LDB(B1, 0, 1); PG8_STAGE(PG8_SB(0, 0), b2, voffB);
            PG8_BAR; PG8_WAIT_L(0); PG8_MMA(0, 1, At, B1); PG8_BAR;
            PG8_LDA(At, 0, 1); PG8_STAGE(PG8_SA(0, 0), a2, voffA);
            PG8_BAR; PG8_WAIT_L(0); PG8_MMA(1, 0, At, B0); PG8_BAR; PG8_SCHED;
            PG8_STAGE(PG8_SB(0, 1), b2 + hstep, voffB);
            PG8_WAIT_V(6); PG8_BAR; PG8_MMA(1, 1, At, B1); PG8_BAR;
            PG8_LDB(B0, 1, 0); PG8_SCHED; PG8_LDA(At, 1, 0); PG8_STAGE(PG8_SA(0, 1), a2 + hstep, voffA);
            PG8_WAIT_L(8); PG8_BAR; PG8_WAIT_L(0); PG8_MMA(0, 0, At, B0); PG8_BAR; PG8_SCHED;
            PG8_LDB(B1, 1, 1); PG8_STAGE(PG8_SB(1, 0), b3, voffB);
            PG8_BAR; PG8_WAIT_L(0); PG8_MMA(0, 1, At, B1); PG8_BAR;
            PG8_LDA(At, 1, 1); PG8_STAGE(PG8_SA(1, 0), a3, voffA);
            PG8_BAR; PG8_WAIT_L(0); PG8_MMA(1, 0, At, B0); PG8_BAR; PG8_SCHED;
            PG8_STAGE(PG8_SB(1, 1), b3 + hstep, voffB);
            PG8_WAIT_V(6); PG8_BAR; PG8_MMA(1, 1, At, B1); PG8_BAR;
            }
        }
        if constexpr (ALIGN_EPI) { if (wr == 0) PG8_BAR; }
        if constexpr (!Epi::AFTER_DRAIN) { E(acc, cur, wr, wc, fr, fq); S.done(cur); }
        if (!has_next) break;
#pragma unroll
        for (int a = 0; a < 2; ++a)
#pragma unroll
            for (int b = 0; b < 2; ++b)
#pragma unroll
                for (int m = 0; m < 4; ++m)
#pragma unroll
                    for (int n = 0; n < 2; ++n) acc[a][b][m][n] = (f32x4){0.f, 0.f, 0.f, 0.f};
        cur = nxt; cA = nA; cB = nB; ++ui;
        if constexpr (ALIGN_EPI) { if (wr == 1) PG8_BAR; }
    }
    PG8_WAIT_V(0);
    if constexpr (!ALIGN_EPI) { if (wr == 0) PG8_BAR; }
    PG8_BAR;
    if constexpr (Epi::AFTER_DRAIN) { E.fused(acc, cur, wr, wc, fr, fq, lds, wid, lane); S.done(cur); }
#undef PG8_SA
#undef PG8_SB
#undef PG8_STAGE
#undef PG8_LDA
#undef PG8_LDB
#undef PG8_MMA
#undef PG8_WAIT_V
#undef PG8_WAIT_L
#undef PG8_BAR
#undef PG8_SCHED
}
}

namespace att {
typedef unsigned short bf16;
typedef short bf16x8 __attribute__((ext_vector_type(8)));
typedef short s16x4 __attribute__((ext_vector_type(4)));
typedef float f32x16 __attribute__((ext_vector_type(16)));
typedef float f32x4 __attribute__((ext_vector_type(4)));
typedef unsigned u32x4 __attribute__((ext_vector_type(4)));
constexpr int D = 128, NW = 8, QBLK = 32, KVBLK = 64, QB = NW * QBLK, LD = 2048;
constexpr int SHM_V = KVBLK * D * 2, SHM_K = KVBLK * D * 2;
constexpr int QPMAX = 7;
template <class T> struct QPark { static constexpr int N = 3; };
template <> struct QPark<float> { static constexpr int N = 7; };
constexpr int OFF_WS = 2 * SHM_V + 2 * SHM_K, WS_WAVE = 768, OFF_QP = OFF_WS + NW * WS_WAVE, LDS_BYTES = OFF_QP + QPMAX * 64 * NW * 16;
constexpr float SCALE = 0.08838834764831845f, THR = 8.f, L2E = 1.4426950408889634f;
template <class A, class Bt> struct same_t { static constexpr bool v = false; };
template <class A> struct same_t<A, A> { static constexpr bool v = true; };
#define KSWZ(row, colB) ((row) * 256 + ((colB) ^ (((row) & 7) << 4)))
#define SBAR() __builtin_amdgcn_sched_barrier(0)
__device__ __forceinline__ int v_st(int k, int c) { const int kk = (k & ~0xC) | ((k & 4) << 1) | ((k & 8) >> 1); return ((kk >> 3) * 4 + (c >> 5)) * 512 + ((kk & 7) * 32 + (c & 31)) * 2; }
__device__ __forceinline__ int v_rd_base(int lane) { return ((lane & 3) << 3) | (((lane >> 2) & 3) << 6) | (((lane >> 4) & 1) << 5) | (((lane >> 5) & 1) << 8); }
constexpr int v_rd_off(int d0, int ks, int half) { return d0 * 512 + ks * 4096 + half * 2048; }
__device__ __forceinline__ int crow(int r, int hi) { return (r & 3) + 8 * (r >> 2) + 4 * hi; }
__device__ __forceinline__ unsigned cvtpk(float lo, float hi) { unsigned r; asm volatile("v_cvt_pk_bf16_f32 %0, %1, %2" : "=v"(r) : "v"(lo), "v"(hi)); return r; }
__device__ __forceinline__ bf16x8 pack8(f32x4 a, f32x4 b) { u32x4 w = {cvtpk(a[0], a[1]), cvtpk(a[2], a[3]), cvtpk(b[0], b[1]), cvtpk(b[2], b[3])}; return *reinterpret_cast<bf16x8*>(&w); }
template <class T> __device__ __forceinline__ const __attribute__((address_space(1))) T* uni(const T* p) {
    const unsigned long long v = (unsigned long long)p; const unsigned lo = (unsigned)__builtin_amdgcn_readfirstlane((int)(unsigned)v), hi = (unsigned)__builtin_amdgcn_readfirstlane((int)(unsigned)(v >> 32));
    return (const __attribute__((address_space(1))) T*)(((unsigned long long)hi << 32) | lo);
}
template <class T> __device__ __forceinline__ bf16x8 load8(const __attribute__((address_space(1))) T* p) {
    if constexpr (same_t<T, float>::v) { return pack8(*(const __attribute__((address_space(1))) f32x4*)p, *(const __attribute__((address_space(1))) f32x4*)(p + 4)); }
    else { return *reinterpret_cast<const __attribute__((address_space(1))) bf16x8*>(p); }
}
template <class T> __device__ __forceinline__ bf16x8 load8(const T* p) {
    if constexpr (same_t<T, float>::v) { return pack8(*(const f32x4*)p, *(const f32x4*)(p + 4)); }
    else { return *reinterpret_cast<const bf16x8*>(p); }
}
__device__ __forceinline__ void mask_tile(f32x16& p0, f32x16& p1, int dq) {
    const float NEG = -__builtin_inff();
#pragma unroll
    for (int r = 0; r < 16; ++r) { const int c = (r & 3) + 8 * (r >> 2); if (dq - c < 0) p0[r] = NEG; if (dq - c - 32 < 0) p1[r] = NEG; }
}
__device__ __forceinline__ void partialSM(f32x16& p0, f32x16& p1, float& m_reg, float& mn, float& alpha) {
    float pmax = p0[0];
#pragma unroll
    for (int r = 1; r < 16; ++r) pmax = fmaxf(pmax, p0[r]);
#pragma unroll
    for (int r = 0; r < 16; ++r) pmax = fmaxf(pmax, p1[r]);
    { auto rr = __builtin_amdgcn_permlane32_swap(__float_as_uint(pmax), __float_as_uint(pmax), false, false); pmax = fmaxf(__uint_as_float(rr[0]), __uint_as_float(rr[1])); }
    constexpr float C2 = L2E * SCALE, THR2 = THR * L2E;
    const float pm = pmax * C2;
    if (__builtin_expect(__all(pm - m_reg <= THR2), 1)) { mn = m_reg; alpha = 1.f; }
    else { mn = fmaxf(m_reg, pm); alpha = __builtin_amdgcn_exp2f(m_reg - mn); m_reg = mn; }
    const float mnL = -mn;
#pragma unroll
    for (int r = 0; r < 16; ++r) p0[r] = fmaf(p0[r], C2, mnL);
#pragma unroll
    for (int r = 0; r < 16; ++r) p1[r] = fmaf(p1[r], C2, mnL);
#pragma unroll
    for (int r = 0; r < 16; ++r) p0[r] = __builtin_amdgcn_exp2f(p0[r]);
}
__device__ __forceinline__ void finishSM(f32x16& p0, f32x16& p1, float alpha, float& l_reg, bf16x8& pa0, bf16x8& pa1, bf16x8& pa2, bf16x8& pa3) {
#pragma unroll
    for (int r = 0; r < 16; ++r) p1[r] = __builtin_amdgcn_exp2f(p1[r]);
    float ps = 0;
#pragma unroll
    for (int r = 0; r < 16; ++r) ps += p0[r];
#pragma unroll
    for (int r = 0; r < 16; ++r) ps += p1[r];
    { auto rr = __builtin_amdgcn_permlane32_swap(__float_as_uint(ps), __float_as_uint(ps), false, false); ps = __uint_as_float(rr[0]) + __uint_as_float(rr[1]); }
    l_reg = l_reg * alpha + ps;
#define PK4(P, B_, OUT) do { unsigned a0 = cvtpk(P[B_+0], P[B_+1]), a1 = cvtpk(P[B_+2], P[B_+3]);                          \
        unsigned b0 = cvtpk(P[B_+4], P[B_+5]), b1 = cvtpk(P[B_+6], P[B_+7]);                                             \
        auto r0 = __builtin_amdgcn_permlane32_swap(a0, b0, false, false); auto r1 = __builtin_amdgcn_permlane32_swap(a1, b1, false, false); \
        u32x4 w = {r0[0], r1[0], r0[1], r1[1]}; OUT = *reinterpret_cast<bf16x8*>(&w); } while (0)
    PK4(p0, 0, pa0); PK4(p0, 8, pa1); PK4(p1, 0, pa2); PK4(p1, 8, pa3);
#undef PK4
}
template <int KB, int QP>
__device__ __forceinline__ void qkt(f32x16& p0, f32x16& p1, const char* K_lds, const char* wl, int r32, int hi, const bf16x8* qr, const char* qp) {
#pragma unroll
    for (int g = 0; g < 4; ++g) { const f32x4 a = *reinterpret_cast<const f32x4*>(wl + 256 + KB * 256 + g * 32), b = *reinterpret_cast<const f32x4*>(wl + 256 + KB * 256 + 128 + g * 32);
        p0[4 * g] = a[0]; p0[4 * g + 1] = a[1]; p0[4 * g + 2] = a[2]; p0[4 * g + 3] = a[3]; p1[4 * g] = b[0]; p1[4 * g + 1] = b[1]; p1[4 * g + 2] = b[2]; p1[4 * g + 3] = b[3]; }
    const char* kb[4];
#pragma unroll
    for (int dd = 0; dd < 4; ++dd) kb[dd] = K_lds + KB * SHM_K + KSWZ(r32, (dd * 16 + hi * 8) * 2);
#pragma unroll
    for (int d0 = 0; d0 < 8; ++d0) { const char* a = kb[d0 & 3] + (d0 >> 2) * 128;
        bf16x8 b0 = *reinterpret_cast<const bf16x8*>(a);
        bf16x8 b1 = *reinterpret_cast<const bf16x8*>(a + 32 * 256);
        const bf16x8 q = d0 < 8 - QP ? qr[d0] : *reinterpret_cast<const bf16x8*>(qp + (d0 - (8 - QP)) * (64 * NW * 16));
        p0 = __builtin_amdgcn_mfma_f32_32x32x16_bf16(b0, q, p0, 0, 0, 0);
        p1 = __builtin_amdgcn_mfma_f32_32x32x16_bf16(b1, q, p1, 0, 0, 0); }
}
template <int VB>
__device__ __forceinline__ void pv_tile(f32x16* o, int vb0, bf16x8 pa0, bf16x8 pa1, bf16x8 pa2, bf16x8 pa3) {
#define TRRD(dst, off) asm volatile("ds_read_b64_tr_b16 %0, %1 offset:%2" : "=&v"(dst) : "v"(vb0), "i"(off) : "memory")
#define PV_D0(d0) do { s16x4 l0, l1, l2, l3, h0, h1, h2, h3; constexpr int b_ = VB * SHM_V + v_rd_off(d0, 0, 0);   \
        TRRD(l0, b_); TRRD(h0, b_ + 2048); TRRD(l1, b_ + 4096); TRRD(h1, b_ + 6144); TRRD(l2, b_ + 8192); TRRD(h2, b_ + 10240); TRRD(l3, b_ + 12288); TRRD(h3, b_ + 14336); \
        asm volatile("s_waitcnt lgkmcnt(0)" ::: "memory"); SBAR();   \
        o[d0] = __builtin_amdgcn_mfma_f32_32x32x16_bf16(pa0, (bf16x8){l0[0], l0[1], l0[2], l0[3], h0[0], h0[1], h0[2], h0[3]}, o[d0], 0, 0, 0);   \
        o[d0] = __builtin_amdgcn_mfma_f32_32x32x16_bf16(pa1, (bf16x8){l1[0], l1[1], l1[2], l1[3], h1[0], h1[1], h1[2], h1[3]}, o[d0], 0, 0, 0);   \
        o[d0] = __builtin_amdgcn_mfma_f32_32x32x16_bf16(pa2, (bf16x8){l2[0], l2[1], l2[2], l2[3], h2[0], h2[1], h2[2], h2[3]}, o[d0], 0, 0, 0);   \
        o[d0] = __builtin_amdgcn_mfma_f32_32x32x16_bf16(pa3, (bf16x8){l3[0], l3[1], l3[2], l3[3], h3[0], h3[1], h3[2], h3[3]}, o[d0], 0, 0, 0); } while (0)
    PV_D0(0); PV_D0(1); PV_D0(2); PV_D0(3);
#undef PV_D0
#undef TRRD
}
template <class TIn> struct BlockRef { unsigned q, k, v, k2, v2, nf, o; int P0, skv, qrows, split; };
struct KVBase { const char* k1; const char* v1; const char* kv2; };
#define BQ(ref) ((const bf16*)(wsb + (ref).q))
#define BK(ref) ((const TIn*)(kvb.k1 + (ref).k))
#define BV(ref) ((const TIn*)(kvb.v1 + (ref).v))
#define BNF(ref) ((const float*)(wsb + (ref).nf))
template <class T> struct Stg { bf16x8 v; __device__ __forceinline__ void ld(const __attribute__((address_space(1))) T* p) { v = *reinterpret_cast<const __attribute__((address_space(1))) bf16x8*>(p); } __device__ __forceinline__ bf16x8 get() const { return v; } };
template <> struct Stg<float> { f32x4 a, b; __device__ __forceinline__ void ld(const __attribute__((address_space(1))) float* p) { a = *(const __attribute__((address_space(1))) f32x4*)p; b = *(const __attribute__((address_space(1))) f32x4*)(p + 4); } __device__ __forceinline__ bf16x8 get() const { return pack8(a, b); } };
template <class TIn> struct Seam {
    bf16x8 qr[8];
    Stg<TIn> st_v0, st_v1, st_k0, st_k1;
    float st_nf;
};
#define ROW(p, k0, rr) (uni((p) + (size_t)((k0) + (rr)) * LD) + lane_kv)
#define VMW() asm volatile("s_waitcnt vmcnt(0)" ::: "memory")
#define VMWN(n) asm volatile("s_waitcnt vmcnt(%0)" :: "i"(n) : "memory")
#define SLOAD_H(Kp, Vp, k0) do { S.st_v0.ld(ROW(Vp, k0, 0)); S.st_v1.ld(ROW(Vp, k0, 32)); S.st_k0.ld(ROW(Kp, k0, 0)); S.st_k1.ld(ROW(Kp, k0, 32)); } while (0)
#define SWRITE_HK(bf) do { *(bf16x8*)(K_lds + (bf) * SHM_K + kws) = S.st_k0.get(); *(bf16x8*)(K_lds + (bf) * SHM_K + kws + 32 * 256) = S.st_k1.get(); } while (0)
#define SWRITE_HV(bf) do { *(bf16x8*)(V_lds + (bf) * SHM_V + vst0) = S.st_v0.get(); *(bf16x8*)(V_lds + (bf) * SHM_V + vst1) = S.st_v1.get(); } while (0)
#define NFLOAD(ref, k0) do { S.st_nf = BNF(ref)[(k0) + lane]; } while (0)
#define NFWRITE(bf) do { nf_l[(bf) * 64 + lane] = S.st_nf; } while (0)
#define KSRC(ref, k0) ((k0) >= (ref).split ? (const TIn*)(kvb.kv2 + (ref).k2) : BK(ref))
#define VSRC(ref, k0) ((k0) >= (ref).split ? (const TIn*)(kvb.kv2 + (ref).v2) : BV(ref))
template <class TIn>
__device__ __forceinline__ int fox_jlo(const char* wsb, const BlockRef<TIn>& r, float D, int lane) {
    int j_hi = (r.P0 + QB - 1) / KVBLK + 1; if (j_hi > r.skv / KVBLK) j_hi = r.skv / KVBLK;
    const float* nf = (const float*)(wsb + r.nf);
    const float ref = nf[r.P0] - D; const int j = lane < j_hi ? lane : j_hi - 1;
    const unsigned long long keep = __ballot(nf[KVBLK * j + KVBLK - 1] >= ref);
    int jl = keep ? __builtin_ctzll(keep) : 0; const int jd = r.P0 / KVBLK;
    jl = jl < jd ? jl : jd;
    return __builtin_amdgcn_readfirstlane(jl);
}
template <class TIn>
__device__ __forceinline__ void fox_prime(const char* wsb, const KVBase& kvb, const BlockRef<TIn>& cur, float Dskip, char* lds, Seam<TIn>& S) {
    const int tid = threadIdx.x, wid = __builtin_amdgcn_readfirstlane(tid >> 6), lane = tid & 63, r32 = lane & 31, hi = lane >> 5;
    const int sr = tid >> 4, sc = (tid & 15) * 8, kws = KSWZ(sr, sc * 2); char* K_lds = lds + 2 * SHM_V; float* nf_l = (float*)(lds + OFF_WS + wid * WS_WAVE + 256);
    const unsigned lane_kv = (unsigned)(sr * LD + sc), lane_q = (unsigned)(r32 * LD + hi * 8);
    const int qrow0 = wid * QBLK < cur.qrows ? wid * QBLK : 0;
    for (int d0 = 0; d0 < 8; ++d0) S.qr[d0] = load8<bf16>(uni(BQ(cur) + (size_t)qrow0 * LD + d0 * 16) + lane_q);
    const int kb0 = fox_jlo<TIn>(wsb, cur, Dskip, lane) * KVBLK;
    NFLOAD(cur, kb0);
    SLOAD_H(KSRC(cur, kb0), VSRC(cur, kb0), kb0); VMW(); SWRITE_HK(0); NFWRITE(0);
    __syncthreads();
}
template <class TIn>
__device__ __forceinline__ void fox_block(const char* wsb, char* wsw, const KVBase& kvb, const BlockRef<TIn>& cur, const BlockRef<TIn>& nxt, float Dskip, char* lds, Seam<TIn>& S) {
    constexpr int QP = QPark<TIn>::N;
    const int tid = threadIdx.x, wid = __builtin_amdgcn_readfirstlane(tid >> 6), lane = tid & 63, r32 = lane & 31, hi = lane >> 5;
    int j_hi = (cur.P0 + QB - 1) / KVBLK + 1; if (j_hi > cur.skv / KVBLK) j_hi = cur.skv / KVBLK;
    const int j_lo = fox_jlo<TIn>(wsb, cur, Dskip, lane), NT = j_hi - j_lo;
    const int qlo = cur.P0 + wid * QBLK, qm = qlo + r32 - 4 * hi;
    char* V_lds = lds; char* K_lds = lds + 2 * SHM_V;
    char* wsw_l = lds + OFF_WS + wid * WS_WAVE; float* li_l = (float*)wsw_l, * al_l = (float*)(wsw_l + 128), * nf_l = (float*)(wsw_l + 256);
    const char* wl = wsw_l + hi * 16;
    float m_reg = -1e30f, l_reg = 0; f32x16 o[4] = {};
    const int sr = tid >> 4, sc = (tid & 15) * 8, vst0 = v_st(sr, sc), vst1 = v_st(32 + sr, sc), kws = KSWZ(sr, sc * 2);
    const int vb0 = (int)(uintptr_t)V_lds + v_rd_base(lane);
    const unsigned lane_kv = (unsigned)(sr * LD + sc), lane_q = (unsigned)(r32 * LD + hi * 8);
    const bool wlive = wid * QBLK < cur.qrows;
    char* qp = lds + OFF_QP + tid * 16;
#pragma unroll
    for (int j = 0; j < QP; ++j) *reinterpret_cast<bf16x8*>(qp + j * (64 * NW * 16)) = S.qr[8 - QP + j];
#define RESC(a) do { if (__any((a) < 1.f)) { if (hi == 0) al_l[r32] = (a); asm volatile("s_waitcnt lgkmcnt(0)" ::: "memory");              \
                     for (int d_ = 0; d_ < 4; ++d_) for (int r = 0; r < 16; ++r) o[d_][r] *= *(const float*)(wl + 128 + 4 * ((r & 3) + 8 * (r >> 2))); } } while (0)
#define KBASE(t) ((j_lo + (t)) * KVBLK)
#define MASKT(P0_, P1_, t) do { const int kb_ = KBASE(t); if (kb_ + KVBLK - 1 > qlo) mask_tile(P0_, P1_, qm - kb_); } while (0)
    constexpr int NQL = 8;
#define SEAM_K0() do { VMWN(NQL); SWRITE_HK(0); NFWRITE(0); SBAR(); } while (0)
    f32x16 pA0, pA1, pB0, pB1; float mnA, mnB, alA, alB; bf16x8 pa0, pa1, pa2, pa3;
    SWRITE_HV(0); SBAR();
    if (NT > 1) { NFLOAD(cur, KBASE(1)); SLOAD_H(KSRC(cur, KBASE(1)), VSRC(cur, KBASE(1)), KBASE(1)); }
    SBAR(); if (wlive) { qkt<0, QP>(pA0, pA1, K_lds, wl, r32, hi, S.qr, qp);
    MASKT(pA0, pA1, 0); partialSM(pA0, pA1, m_reg, mnA, alA); }
    if (NT > 1) { VMW(); SWRITE_HV(1); SWRITE_HK(1); NFWRITE(1); }
    __syncthreads();
#define HALF_STEP(PX0, PX1, mnX, alX, PY0, PY1, alY, t, KB, VB, SB) do {                                                      \
        SBAR(); if (wlive) { qkt<KB, QP>(PX0, PX1, K_lds, wl, r32, hi, S.qr, qp);                                              \
        finishSM(PY0, PY1, alY, l_reg, pa0, pa1, pa2, pa3); } SBAR();                                                         \
        if ((t) + 1 < NT) { NFLOAD(cur, KBASE((t) + 1)); SLOAD_H(KSRC(cur, KBASE((t) + 1)), VSRC(cur, KBASE((t) + 1)), KBASE((t) + 1)); SBAR(); }          \
        if (wlive) { pv_tile<VB>(o, vb0, pa0, pa1, pa2, pa3); MASKT(PX0, PX1, (t)); partialSM(PX0, PX1, m_reg, mnX, alX); }    \
        __syncthreads();                                                                                                      \
        if ((t) + 1 < NT) { VMW(); SWRITE_HV(SB); SWRITE_HK(SB); NFWRITE(SB); }                                             \
        if (wlive) RESC(alX); __syncthreads(); } while (0)
    for (int t = 1; t + 1 < NT; t += 2) {
        HALF_STEP(pB0, pB1, mnB, alB, pA0, pA1, alA, t, 1, 0, 0);
        HALF_STEP(pA0, pA1, mnA, alA, pB0, pB1, alB, t + 1, 0, 1, 1);
    }
    const bool even = (NT & 1) == 0;
    if (even) { SBAR(); if (wlive) qkt<1, QP>(pB0, pB1, K_lds, wl, r32, hi, S.qr, qp); SBAR(); }
    const int qrown0 = wid * QBLK < nxt.qrows ? wid * QBLK : 0;
    const int kbn = fox_jlo<TIn>(wsb, nxt, Dskip, lane) * KVBLK;
    NFLOAD(nxt, kbn);
    SLOAD_H(KSRC(nxt, kbn), VSRC(nxt, kbn), kbn);
    SBAR();
#pragma unroll
    for (int d0 = 0; d0 < 8; ++d0) S.qr[d0] = load8<bf16>(uni(BQ(nxt) + (size_t)qrown0 * LD + d0 * 16) + lane_q);
    SBAR();
    if (wlive) { finishSM(pA0, pA1, alA, l_reg, pa0, pa1, pa2, pa3); } SBAR();
    if (wlive) pv_tile<0>(o, vb0, pa0, pa1, pa2, pa3);
    if (even) { if (wlive) { MASKT(pB0, pB1, NT - 1); partialSM(pB0, pB1, m_reg, mnB, alB); } __syncthreads(); if (wlive) { RESC(alB);
        finishSM(pB0, pB1, alB, l_reg, pa0, pa1, pa2, pa3); } SBAR(); if (wlive) pv_tile<1>(o, vb0, pa0, pa1, pa2, pa3); }
    SBAR(); SEAM_K0();
    if (hi == 0) li_l[r32] = l_reg; asm volatile("s_waitcnt lgkmcnt(0)" ::: "memory");
    float rli[16];
#pragma unroll
    for (int r = 0; r < 16; ++r) rli[r] = __builtin_amdgcn_rcpf(*(const float*)(wl + 4 * ((r & 3) + 8 * (r >> 2))));
    bf16* Ow = (bf16*)(wsw + cur.o) + (size_t)(wid * QBLK) * LD; const unsigned lane_o = (unsigned)(4 * hi * LD + r32);
    if (wlive) {
#pragma unroll
    for (int r = 0; r < 16; ++r) { bf16* Or = Ow + (size_t)((r & 3) + 8 * (r >> 2)) * LD;
#pragma unroll
        for (int d0 = 0; d0 < 4; ++d0) { const float v = o[d0][r] * rli[r]; const float vn = __shfl_xor(v, 1);
            if ((r32 & 1) == 0) *(unsigned*)(Or + d0 * 32 + lane_o) = cvtpk(v, vn); } } }
    __syncthreads();
#undef RESC
#undef KBASE
#undef MASKT
#undef SEAM_K0
#undef HALF_STEP
}
#undef ROW
#undef VMW
#undef VMWN
#undef SLOAD_H
#undef SWRITE_HK
#undef SWRITE_HV
#undef NFLOAD
#undef NFWRITE
#undef KSRC
#undef VSRC
#undef BQ
#undef BK
#undef BV
#undef BNF
#undef KSWZ
#undef SBAR
}


constexpr int DM = 4096, DFF = 11008, NPR = 8192, NSR = 2048, MR = NPR + NSR;
constexpr int SEQ = 4096, NBP = 2, NBS = 32, TS = 64, PAST = 1024, SKVS = PAST + TS;
constexpr int NH = 16, HD = 128, DA = 2048, DS = 2048, NG = 128, SG = 16, NP = 64, NIN = 8208;
constexpr float EPS = 1e-6f;
constexpr int NWAVES = 8;
constexpr int N_PHASES = 15;
#ifndef GEMM_ALIGN
#define GEMM_ALIGN true
#endif
#ifndef GEMM_SP2
#define GEMM_SP2 true
#endif
#ifndef P8_HOSTS_OB_NORM
#define P8_HOSTS_OB_NORM 1
#endif
#ifndef P4_PSHUF
#define P4_PSHUF 1
#endif
#ifndef P7_ROTATE
#define P7_ROTATE 3
#endif
#ifndef P2_HOSTS_CONVERSION
#define P2_HOSTS_CONVERSION 1
#endif
#ifndef MK_ONE_LAUNCH
#define MK_ONE_LAUNCH 1
#endif

constexpr size_t O_Y = 0, O_KP = (size_t)MR * DM, O_VP = O_KP + (size_t)NPR * DA, O_LP = O_VP + (size_t)NPR * DA, O_SRP = O_LP + (size_t)NPR * NH, O_SIP = O_SRP + NBP * NG * NP,
                 O_KS = O_SIP + NBP * NG * NP, O_VS = O_KS + (size_t)NSR * DA, O_LS = O_VS + (size_t)NSR * DA, O_SRS = O_LS + (size_t)NSR * NH, O_SIS = O_SRS + NBS * NG * NP, O_END = O_SIS + NBS * NG * NP;
static_assert(O_END == 84606976, "output size");

constexpr size_t MiB = 1u << 20;
constexpr size_t WS_CTL = 0, CTL_ZERO_BYTES = 32768;
constexpr size_t WS_W13A = 2 * MiB;
constexpr size_t WS_W2A = WS_W13A + 172 * MiB;
constexpr size_t WS_W13B = WS_W2A + 86 * MiB;
constexpr size_t WS_W2B = WS_W13B + 172 * MiB;
constexpr size_t WS_WIN = WS_W2B + 86 * MiB;
constexpr size_t WS_WF = WS_WIN + 64 * MiB;
constexpr size_t WS_WGLU = WS_WF + 1 * MiB;
constexpr size_t WS_WOUT = WS_WGLU + 8 * MiB;
constexpr size_t WS_XN = WS_WOUT + 32 * MiB;
constexpr size_t WS_H = WS_XN + 80 * MiB;
constexpr size_t WS_ZQ = WS_H;
constexpr size_t WS_ZK = WS_H + 80 * MiB;
constexpr size_t WS_QN = WS_H + 160 * MiB;
constexpr size_t WS_U = WS_H + 215 * MiB;
constexpr size_t WS_OB = WS_U + 80 * MiB;
constexpr size_t WS_YS = WS_OB + 40 * MiB;
constexpr size_t WS_YG = WS_YS + 40 * MiB;
constexpr size_t WS_KBP = WS_YG + 40 * MiB;
constexpr size_t WS_VBP = WS_KBP + 32 * MiB;
constexpr size_t WS_KBS = WS_VBP + 32 * MiB;
constexpr size_t WS_VBS = WS_KBS + 136 * MiB;
constexpr size_t WS_NFP = WS_VBS + 136 * MiB;
constexpr size_t WS_FQP = WS_NFP + 1 * MiB;
constexpr size_t WS_NFS = WS_FQP + 1 * MiB;
constexpr size_t WS_FQS = WS_NFS + 3 * MiB;
constexpr size_t WS_LAMB = WS_FQS + 1 * MiB;
constexpr size_t WS_LAM64 = WS_LAMB + 1 * MiB;
constexpr size_t WS_BB = WS_LAM64 + 1 * MiB;
constexpr size_t WS_CC = WS_BB + 1 * MiB;
constexpr size_t WS_SLOC = WS_CC + 1 * MiB;
constexpr size_t WS_XIN = WS_SLOC + 8 * MiB;
constexpr size_t WS_S2 = WS_XIN + 8 * MiB;
constexpr size_t WS_END = WS_S2 + 32 * MiB;
static_assert(WS_END <= 1900 * MiB && WS_END < 0xFFFFFFFFull, "workspace map (the attention body addresses it with 32-bit byte offsets)");
constexpr int CW_BAR = 4096;

constexpr int RING_OFF = 0, RING_BYTES = 131072;
constexpr int LDSCTL_OFF = RING_BYTES, MISC_OFF = LDSCTL_OFF + 320;
constexpr int LDS_BYTES = 147456;

#define GAS __attribute__((address_space(1)))
#define LAS __attribute__((address_space(3)))
typedef unsigned short bf16;
typedef unsigned v4u __attribute__((ext_vector_type(4)));
typedef unsigned v2u __attribute__((ext_vector_type(2)));
typedef float f32x4 __attribute__((ext_vector_type(4)));
typedef short bf16x8 __attribute__((ext_vector_type(8)));
#define LDS_WAIT() asm volatile("s_waitcnt lgkmcnt(0)" ::: "memory")
#define VM_WAIT() asm volatile("s_waitcnt vmcnt(0)" ::: "memory")
__device__ __forceinline__ unsigned pk2(float lo, float hi) { unsigned r; asm volatile("v_cvt_pk_bf16_f32 %0, %1, %2" : "=v"(r) : "v"(lo), "v"(hi)); return r; }
__device__ __forceinline__ float bf_lo(unsigned w) { return __uint_as_float(w << 16); }
__device__ __forceinline__ float bf_hi(unsigned w) { return __uint_as_float(w & 0xffff0000u); }

#define XB_TMO      128
#define XB_XCNT(j)  (256  + 64 * (j))
#define XB_XSUB(j)  (1280 + 64 * (j))
#define XB_XGEN(j)  (2304 + 64 * (j))
#define XB_TOP      3328
#define XB_TOPGEN   3392
#define XCD_BAR_WORDS 3456
#define XB_SPIN_CAP (1u << 18)

__device__ __forceinline__ unsigned xb_ld(unsigned* p)              { return __hip_atomic_load(p, __ATOMIC_RELAXED, __HIP_MEMORY_SCOPE_AGENT); }
__device__ __forceinline__ unsigned xb_add(unsigned* p, unsigned v) { return __hip_atomic_fetch_add(p, v, __ATOMIC_RELAXED, __HIP_MEMORY_SCOPE_AGENT); }
__device__ __forceinline__ unsigned xb_xcc_id() { return (unsigned)__builtin_amdgcn_s_getreg((3 << 11) | 20) & 0xFu; }
#define XB_SPIN(cond, bar) do { unsigned _sp = 0; while (cond) { __builtin_amdgcn_s_sleep(1); \
    if ((++_sp & 255u) == 0u) { if (xb_ld(&(bar)[XB_TMO])) break; if (_sp > XB_SPIN_CAP) { atomicAdd(&(bar)[XB_TMO], 1u); break; } } } } while (0)

struct XcdBarrier {
    unsigned* bar; unsigned x;
    volatile LAS unsigned* st;
};

__device__ __forceinline__ XcdBarrier xcd_barrier_post(unsigned* bar, volatile LAS unsigned* st) {
    XcdBarrier b; b.bar = bar; b.x = xb_xcc_id(); b.st = st;
    if (threadIdx.x == 0) (void)xb_add(&bar[XB_XCNT(b.x)], 1u);
    return b;
}
__device__ __forceinline__ void xcd_barrier_complete(unsigned* bar, unsigned x, unsigned& nloc, unsigned& nx) {
    const unsigned G = gridDim.x * gridDim.y * gridDim.z;
    unsigned sum, cnt, mine, sp = 0u;
    for (;;) {
        sum = 0u; cnt = 0u; mine = 0u;
#pragma unroll
        for (unsigned j = 0; j < 16; ++j) { const unsigned c = xb_ld(&bar[XB_XCNT(j)]); sum += c; cnt += (c > 0u) ? 1u : 0u; mine = (j == x) ? c : mine; }
        if (sum == G) break;
        __builtin_amdgcn_s_sleep(1);
        if ((++sp & 255u) == 0u) { if (xb_ld(&bar[XB_TMO])) break; if (sp > XB_SPIN_CAP) { atomicAdd(&bar[XB_TMO], 1u); break; } }
    }
    nloc = mine > 0u ? mine : 1u; nx = cnt > 0u ? cnt : 1u;
}

__device__ __forceinline__ void xcd_barrier(const XcdBarrier& b) {
    asm volatile("s_waitcnt vmcnt(0)" ::: "memory");
    __syncthreads();
    if (threadIdx.x == 0) {
        unsigned* bar = b.bar;
        __builtin_amdgcn_s_waitcnt(0);
        unsigned nloc = b.st[0], nx = b.st[1];
        if (nloc == 0u) { xcd_barrier_complete(bar, b.x, nloc, nx); b.st[0] = nloc; b.st[1] = nx; }
        const unsigned old = xb_add(&bar[XB_XSUB(b.x)], 1u);
        const unsigned gen = old / nloc;
        if (old + 1u == (gen + 1u) * nloc) {
            __builtin_amdgcn_fence(__ATOMIC_RELEASE, "agent");
            asm volatile("s_waitcnt vmcnt(0)" ::: "memory");
            const unsigned og = xb_add(&bar[XB_TOP], 1u);
            const unsigned tg = og / nx;
            if (og + 1u == (tg + 1u) * nx) xb_add(&bar[XB_TOPGEN], 1u);
            else XB_SPIN(xb_ld(&bar[XB_TOPGEN]) == tg, bar);
            __builtin_amdgcn_fence(__ATOMIC_ACQUIRE, "agent");
            xb_add(&bar[XB_XGEN(b.x)], 1u);
            asm volatile("s_waitcnt vmcnt(0)" ::: "memory");
        } else {
            XB_SPIN(xb_ld(&bar[XB_XGEN(b.x)]) == gen, bar);
            __builtin_amdgcn_fence(__ATOMIC_ACQUIRE, "agent");
            asm volatile("s_waitcnt vmcnt(0)" ::: "memory");
        }
    }
    __syncthreads();
}

constexpr int QKTAB_OFF = LDSCTL_OFF + 1024;
constexpr int ARGTAB_OFF = LDSCTL_OFF + 512;
__device__ __forceinline__ const float* inp_ptr(LAS unsigned char* lds, int i) {
    const LAS unsigned* t = (const LAS unsigned*)(lds + ARGTAB_OFF) + 2 * i;
    const unsigned lo = (unsigned)__builtin_amdgcn_readfirstlane((int)t[0]), hi = (unsigned)__builtin_amdgcn_readfirstlane((int)t[1]);
    return (const float*)(const GAS float*)(((unsigned long long)hi << 32) | lo);
}
struct Wv { int lane, wave, gw, ngw; };
__device__ __forceinline__ float wave_sum(float v) {
#pragma unroll
    for (int o = 1; o < 64; o <<= 1) v += __shfl_xor(v, o);
    return v;
}
__device__ __forceinline__ float fsig(float x) { return __builtin_amdgcn_rcpf(1.0f + __builtin_amdgcn_exp2f(-1.4426950408889634f * x)); }
__device__ __forceinline__ bf16x8 pack8f(f32x4 a, f32x4 b) { v4u w = {pk2(a[0], a[1]), pk2(a[2], a[3]), pk2(b[0], b[1]), pk2(b[2], b[3])}; return *reinterpret_cast<bf16x8*>(&w); }

__device__ __forceinline__ void transpose_item(const float* W, int ldw, int K, int k0, int nsrc0, bf16* WT, int drow0, LAS float* scr, int lane) {
#pragma unroll 8
    for (int i = 0; i < 32; ++i) { const int kk = 2 * i + (lane >> 5); scr[kk * 33 + (lane & 31)] = __builtin_nontemporal_load(W + (size_t)(k0 + kk) * ldw + nsrc0 + (lane & 31)); }
    LDS_WAIT(); asm volatile("" ::: "memory");
    const int c = lane & 7;
#pragma unroll
    for (int j = 0; j < 4; ++j) { const int n = (lane >> 3) + 8 * j; const LAS float* s = scr + (8 * c) * 33 + n;
        v4u o; o.x = pk2(s[0 * 33], s[1 * 33]); o.y = pk2(s[2 * 33], s[3 * 33]); o.z = pk2(s[4 * 33], s[5 * 33]); o.w = pk2(s[6 * 33], s[7 * 33]);
        *(GAS v4u*)(WT + (size_t)(drow0 + n) * K + k0 + 8 * c) = o; }
    LDS_WAIT(); asm volatile("" ::: "memory");
}
__device__ __forceinline__ void rms_row_4096(float* xrow, const float* addrow, const float* gain, bf16* orow, int lane) {
    GAS f32x4* xr = (GAS f32x4*)xrow + lane;
    f32x4 v[16]; float s = 0.f;
    if (addrow) { const GAS f32x4* ar = (const GAS f32x4*)addrow + lane;
#pragma unroll
        for (int j = 0; j < 16; ++j) { v[j] = xr[64 * j] + ar[64 * j]; xr[64 * j] = v[j]; } }
    else {
#pragma unroll
        for (int j = 0; j < 16; ++j) v[j] = xr[64 * j]; }
#pragma unroll
    for (int j = 0; j < 16; ++j) s += (v[j].x * v[j].x + v[j].y * v[j].y) + (v[j].z * v[j].z + v[j].w * v[j].w);
    const float rstd = rsqrtf(wave_sum(s) * (1.f / 4096.f) + EPS);
    const GAS f32x4* gr = (const GAS f32x4*)gain + lane;
    GAS v2u* o8 = (GAS v2u*)orow + lane;
#pragma unroll
    for (int j = 0; j < 16; ++j) { const f32x4 g = gr[64 * j]; v2u w; w.x = pk2(v[j].x * rstd * g.x, v[j].y * rstd * g.y); w.y = pk2(v[j].z * rstd * g.z, v[j].w * rstd * g.w); o8[64 * j] = w; }
}
__device__ __forceinline__ void ssm_lam(const float* lam_re, const float* lam_im, const float* log_dt, int g, int p, float& lr, float& li, float& cr, float& ci) {
    const float a = lam_re[g * NP + p], b = lam_im[g * NP + p], dt = expf(log_dt[g]);
    const float ar = a * dt, th = b * dt;
    const float er = expf(ar), sn = sinf(th), cs = cosf(th);
    lr = er * cs; li = er * sn;
    const float sh = sinf(0.5f * th), nr = expm1f(ar) * cs - 2.f * sh * sh, ni = li, den = a * a + b * b;
    cr = (nr * a + ni * b) / den; ci = (ni * a - nr * b) / den;
}
__device__ __forceinline__ float log_sigmoid(float z) { return z >= 0.f ? -log1pf(expf(-z)) : z - log1pf(expf(z)); }

constexpr int XT_PITCH = 136;
template <bool FULL>
__device__ __forceinline__ void ssm_chunk(const float* U, int row0, int g, const float* lamb, const bf16* BB, const bf16* CC, const float* dskip, bf16* YS,
                                          float& xr, float& xi, LAS float* bu_l, LAS bf16* xt_l, int lane) {
    typedef float f32x2 __attribute__((ext_vector_type(2)));
    const f32x2 lam = *(const f32x2*)(lamb + (g * NP + lane) * 2);
    const float lr = lam.x, li = lam.y;
    bf16x8 bfr[8];
#pragma unroll
    for (int nb = 0; nb < 8; ++nb) bfr[nb] = *(const bf16x8*)(BB + ((size_t)(g * 8 + nb) * 64 + lane) * 8);
    bf16x8 cfr[4];
    if constexpr (FULL) {
#pragma unroll
        for (int kk = 0; kk < 4; ++kk) cfr[kk] = *(const bf16x8*)(CC + ((size_t)(g * 4 + kk) * 64 + lane) * 8);
    }
    const int t16 = lane & 15, kq = lane >> 4;
    f32x4 ua = {0.f, 0.f, 0.f, 0.f}, ub = {0.f, 0.f, 0.f, 0.f};
    if (kq < 2) { const float* up = U + (size_t)(row0 + t16) * DS + g * SG + 8 * kq; ua = *(const f32x4*)up; ub = *(const f32x4*)(up + 4); }
#pragma unroll 1
    for (int sub = 0; sub < 4; ++sub) {
        const int row = row0 + 16 * sub + t16;
        const bf16x8 a = pack8f(ua, ub);
        if (sub < 3 && kq < 2) { const float* up = U + (size_t)(row + 16) * DS + g * SG + 8 * kq; ua = *(const f32x4*)up; ub = *(const f32x4*)(up + 4); }
        f32x4 bacc[8];
#pragma unroll
        for (int nb = 0; nb < 8; ++nb) { const f32x4 z = {0.f, 0.f, 0.f, 0.f}; bacc[nb] = __builtin_amdgcn_mfma_f32_16x16x32_bf16(a, bfr[nb], z, 0, 0, 0); }
        __builtin_amdgcn_sched_barrier(0);
#pragma unroll
        for (int nb = 0; nb < 8; ++nb)
#pragma unroll
            for (int j = 0; j < 4; ++j) bu_l[(4 * kq + j) * 128 + 16 * nb + t16] = bacc[nb][j];
        LDS_WAIT(); __builtin_amdgcn_sched_barrier(0);
        LDS_WAIT(); __builtin_amdgcn_wave_barrier(); asm volatile("" ::: "memory");
        f32x2 bv[16];
#pragma unroll
        for (int t = 0; t < 16; ++t) bv[t] = *(const LAS f32x2*)(bu_l + t * 128 + 2 * lane);
        LDS_WAIT(); __builtin_amdgcn_sched_barrier(0);
        unsigned xw[16];
#pragma unroll
        for (int t = 0; t < 16; ++t) { const float nxr = fmaf(lr, xr, fmaf(-li, xi, bv[t].x)), nxi = fmaf(lr, xi, fmaf(li, xr, bv[t].y)); xr = nxr; xi = nxi;
            if constexpr (FULL) xw[t] = pk2(xr, xi); }
        if constexpr (FULL) {
            __builtin_amdgcn_sched_barrier(0);
#pragma unroll
            for (int t = 0; t < 16; ++t) *(LAS unsigned*)(xt_l + t * XT_PITCH + 2 * lane) = xw[t]; }
        if constexpr (FULL) {
            LDS_WAIT(); __builtin_amdgcn_wave_barrier(); asm volatile("" ::: "memory");
            f32x4 y = {0.f, 0.f, 0.f, 0.f};
#pragma unroll
            for (int kk = 0; kk < 4; ++kk) { const bf16x8 xb = *(const LAS bf16x8*)(xt_l + t16 * XT_PITCH + 32 * kk + 8 * kq); y = __builtin_amdgcn_mfma_f32_16x16x32_bf16(cfr[kk], xb, y, 0, 0, 0); }
            const f32x4 u4 = *(const f32x4*)(U + (size_t)row * DS + g * SG + 4 * kq), d4 = *(const f32x4*)(dskip + g * SG + 4 * kq);
            float o[4];
#pragma unroll
            for (int j = 0; j < 4; ++j) { const float v = y[j] + d4[j] * u4[j]; o[j] = v * fsig(1.5957691216057308f * (v + 0.044715f * v * v * v)); }
            v2u w; w.x = pk2(o[0], o[1]); w.y = pk2(o[2], o[3]);
#if defined(DBG_NO_YS_STORE)
            asm volatile("" :: "v"(w.x), "v"(w.y));
#else
            *(GAS v2u*)(YS + (size_t)row * DS + g * SG + 4 * kq) = w;
#endif
        }
        LDS_WAIT(); __builtin_amdgcn_wave_barrier(); asm volatile("" ::: "memory");
    }
}


struct Args { const float* in[32]; float* out; unsigned char* ws; int ph_lo, ph_hi, sub, pad; };
enum { I_XP = 0, I_XS, I_CK, I_CV, I_CLF, I_SRE, I_SIM, I_NF1, I_W1A, I_W3A, I_W2A, I_NMIX, I_WIN, I_BF, I_QN, I_KN, I_LRE, I_LIM, I_LDT, I_BRE, I_BIM, I_CRE, I_CIM, I_DSK, I_WGLU,
       I_ONA, I_ONS, I_WOUT, I_NF2, I_W1B, I_W3B, I_W2B };

__global__ void __launch_bounds__(NWAVES * 64, 2) fwd_kernel(Args args) {
    extern __shared__ __attribute__((aligned(16))) unsigned char lds_raw[];
    LAS unsigned char* lds = (LAS unsigned char*)lds_raw;
    volatile LAS unsigned* MISC = (volatile LAS unsigned*)(lds + MISC_OFF);
    const int tid = threadIdx.x, lane = tid & 63, wave = __builtin_amdgcn_readfirstlane(tid >> 6);
    const int G = gridDim.x; const int bx = blockIdx.x; const int vcu = (G % 8 == 0) ? (bx % 8) * (G / 8) + bx / 8 : bx;
    Wv W; W.lane = lane; W.wave = wave; W.gw = vcu * NWAVES + wave; W.ngw = G * NWAVES;
    unsigned char* ws = args.ws; float* out = args.out;
    unsigned* ctl = (unsigned*)(ws + WS_CTL);
    bf16* W13A = (bf16*)(ws + WS_W13A); bf16* W2A = (bf16*)(ws + WS_W2A); bf16* W13B = (bf16*)(ws + WS_W13B); bf16* W2B = (bf16*)(ws + WS_W2B);
    bf16* WINT = (bf16*)(ws + WS_WIN); bf16* WFT = (bf16*)(ws + WS_WF); bf16* WGLUT = (bf16*)(ws + WS_WGLU); bf16* WOUTT = (bf16*)(ws + WS_WOUT);
    bf16* XN = (bf16*)(ws + WS_XN); bf16* HB = (bf16*)(ws + WS_H);
    bf16* QNB = (bf16*)(ws + WS_QN); float* UU = (float*)(ws + WS_U);
    bf16* KBP = (bf16*)(ws + WS_KBP); bf16* VBP = (bf16*)(ws + WS_VBP); bf16* KBS = (bf16*)(ws + WS_KBS); bf16* VBS = (bf16*)(ws + WS_VBS);
    bf16* OB = (bf16*)(ws + WS_OB); bf16* YS = (bf16*)(ws + WS_YS); bf16* YG = (bf16*)(ws + WS_YG);
    float* NFP = (float*)(ws + WS_NFP); float* FQP = (float*)(ws + WS_FQP); float* NFS = (float*)(ws + WS_NFS); float* FQS = (float*)(ws + WS_FQS);
    float* LAMB = (float*)(ws + WS_LAMB); float* LAM64 = (float*)(ws + WS_LAM64); bf16* BB = (bf16*)(ws + WS_BB); bf16* CC = (bf16*)(ws + WS_CC);
    float* SLOC = (float*)(ws + WS_SLOC); float* XIN = (float*)(ws + WS_XIN); float* S2 = (float*)(ws + WS_S2);
    float* Y = out + O_Y;

    for (int u = tid; u < (LDS_BYTES - LDSCTL_OFF) / 4; u += NWAVES * 64) ((LAS unsigned*)(lds + LDSCTL_OFF))[u] = 0u;
    __syncthreads();
    if (tid == 0) {
#pragma unroll
        for (int i = 0; i < 32; ++i) ((LAS unsigned long long*)(lds + ARGTAB_OFF))[i] = (unsigned long long)args.in[i]; }
    __syncthreads();
#define INP(i) inp_ptr(lds, (i))
#if MK_ONE_LAUNCH
    XcdBarrier bar = xcd_barrier_post(ctl + CW_BAR, MISC + 8);
#define GRID_BAR() xcd_barrier(bar)
#else
#define GRID_BAR() do { } while (0)
#endif
    const int lo = args.ph_lo, hi = args.ph_hi, sub = args.sub;
#ifndef PHASE_MASK
#define PHASE_MASK 0xFFFFFFFFu
#endif
#define IN(k) ((((PHASE_MASK) >> (k)) & 1u) && lo <= (k) && (k) < hi)
#define BOTH(k) (IN(k) && IN((k) + 1))

    constexpr int CV_I_FF = (DM / 64) * (DFF / 32), CV_I_IN = (DM / 64) * (8192 / 32), CV_I_GLU = (DS / 64) * (DS / 32), CV_NITEMS = 4 * CV_I_FF + CV_I_IN + CV_I_GLU;
#define CONVERT_RANGE(lo_, hi_, w0_, nw_) do { LAS float* scr_ = (LAS float*)(lds + RING_OFF + wave * 16384); \
        for (int it_ = (lo_) + (w0_); it_ < (hi_); it_ += (nw_)) { int r = it_; \
            if (r < 4 * CV_I_FF) { const int which = r / CV_I_FF; r -= which * CV_I_FF; const int kb = r / (DFF / 32), nb = r % (DFF / 32), n0 = 32 * nb; \
                const float* src = INP(which == 0 ? I_W1A : (which == 1 ? I_W3A : (which == 2 ? I_W1B : I_W3B))); \
                transpose_item(src, DFF, DM, 64 * kb, n0, which < 2 ? W13A : W13B, 256 * (n0 / 128) + 128 * (which & 1) + (n0 % 128), scr_, lane); continue; } \
            r -= 4 * CV_I_FF; \
            if (r < CV_I_IN) { const int kb = r / 256, nb = r % 256, n0 = 32 * nb; \
                transpose_item(INP(I_WIN), NIN, DM, 64 * kb, n0 < 6144 ? n0 : n0 + 16, WINT, n0, scr_, lane); continue; } \
            r -= CV_I_IN; \
            { const int kb = r / (DS / 32), nb = r % (DS / 32); transpose_item(INP(I_WGLU), DS, DS, 64 * kb, 32 * nb, WGLUT, 32 * nb, scr_, lane); } } } while (0)
#define TAIL_CONVERT(nwg_, src_, N_, K_, dst_) do { const int extra_ = (nwg_) % G; if (bx >= extra_) { const float* srcp_ = (src_);     \
        LAS float* scr_ = (LAS float*)(lds + RING_OFF + wave * 16384); const int nbk_ = (N_) / 32, nit_ = ((K_) / 64) * nbk_; \
        for (int it_ = (bx - extra_) * NWAVES + wave; it_ < nit_; it_ += (G - extra_) * NWAVES) { const int kb_ = it_ / nbk_, nb_ = it_ % nbk_; \
            transpose_item(srcp_, (N_), (K_), 64 * kb_, 32 * nb_, (dst_), 32 * nb_, scr_, lane); } } } while (0)
    if (IN(0)) {
        LAS float* scr = (LAS float*)(lds + RING_OFF + wave * 16384);
#if P2_HOSTS_CONVERSION
        CONVERT_RANGE(0, 2 * CV_I_FF, W.gw, W.ngw);
#if defined(P2CONV_ONLY_W13B)
        CONVERT_RANGE(4 * CV_I_FF, CV_NITEMS, W.gw, W.ngw);
#endif
#else
        CONVERT_RANGE(0, CV_NITEMS, W.gw, W.ngw);
#endif
        for (int kq = W.gw; kq < DM / 64; kq += W.ngw) { const int k = 64 * kq + lane; const float* s = INP(I_WIN) + (size_t)k * NIN + 6144;
#pragma unroll
            for (int n4 = 0; n4 < 4; ++n4) { const f32x4 v = *(const f32x4*)(s + 4 * n4);
#pragma unroll
                for (int j = 0; j < 4; ++j) WFT[(size_t)(4 * n4 + j) * DM + k] = (bf16)(pk2(v[j], 0.f) & 0xffffu); } }
        { const int gt = W.gw * 64 + lane, ngt = W.ngw * 64;
          const float* lre = INP(I_LRE); const float* lim = INP(I_LIM); const float* ldt = INP(I_LDT);
          for (int i = gt; i < NG * NP; i += ngt) { const int g = i / NP, p = i % NP; float lr, li, cr, ci; ssm_lam(lre, lim, ldt, g, p, lr, li, cr, ci);
              LAMB[2 * i] = lr; LAMB[2 * i + 1] = li; float pr = lr, pi = li;
#pragma unroll
              for (int s = 0; s < 6; ++s) { const float t = pr * pr - pi * pi; pi = 2.f * pr * pi; pr = t; }
              LAM64[2 * i] = pr; LAM64[2 * i + 1] = pi; }
          const float* bre = INP(I_BRE); const float* bim = INP(I_BIM);
          for (int i = gt; i < NG * 8 * 64; i += ngt) { const int g = i / 512, nb = (i / 64) % 8, l = i % 64, kq = l >> 4; v4u w = {0u, 0u, 0u, 0u};
              if (kq < 2) { const int n = 16 * nb + (l & 15), p = n >> 1, ri = n & 1; float lr, li, cr, ci; ssm_lam(lre, lim, ldt, g, p, lr, li, cr, ci);
                  const float* br = bre + ((size_t)(g * NP + p)) * SG + 8 * kq; const float* bi = bim + ((size_t)(g * NP + p)) * SG + 8 * kq; float v[8];
#pragma unroll
                  for (int j = 0; j < 8; ++j) v[j] = ri == 0 ? cr * br[j] - ci * bi[j] : cr * bi[j] + ci * br[j];
                  w.x = pk2(v[0], v[1]); w.y = pk2(v[2], v[3]); w.z = pk2(v[4], v[5]); w.w = pk2(v[6], v[7]); }
              *(v4u*)(BB + (size_t)i * 8) = w; }
          const float* cre = INP(I_CRE); const float* cim = INP(I_CIM);
          for (int i = gt; i < NG * 4 * 64; i += ngt) { const int g = i / 256, kk = (i / 64) % 4, l = i % 64, c = l & 15; float v[8];
#pragma unroll
              for (int j = 0; j < 8; ++j) { const int k = 32 * kk + 8 * (l >> 4) + j, p = k >> 1; v[j] = (k & 1) == 0 ? cre[((size_t)(g * SG + c)) * NP + p] : -cim[((size_t)(g * SG + c)) * NP + p]; }
              v4u w; w.x = pk2(v[0], v[1]); w.y = pk2(v[2], v[3]); w.z = pk2(v[4], v[5]); w.w = pk2(v[6], v[7]);
              *(v4u*)(CC + (size_t)i * 8) = w; } }
        for (int u = W.gw; u < NBS * NH; u += W.ngw) { const int b = u / NH, h = u % NH; const float* src = INP(I_CLF) + ((size_t)b * PAST + 16 * lane) * NH + h; float v[16]; float sm = 0.f;
#pragma unroll
            for (int i = 0; i < 16; ++i) { sm += src[(size_t)i * NH]; v[i] = sm; }
            float incl = sm;
#pragma unroll
            for (int o = 1; o < 64; o <<= 1) { const float t = __shfl_up(incl, o); if (lane >= o) incl += t; }
            const float off = incl - sm; float* nf = NFS + (size_t)u * SKVS + 16 * lane;
#pragma unroll
            for (int i = 0; i < 16; i += 4) *(f32x4*)(nf + i) = (f32x4){v[i] + off, v[i + 1] + off, v[i + 2] + off, v[i + 3] + off} * (-11.313708498984761f);
            if (lane == 63) FQS[(size_t)u * TS] = incl; }
        for (int m = W.gw; m < MR; m += W.ngw) rms_row_4096((float*)(m < NPR ? INP(I_XP) + (size_t)m * DM : INP(I_XS) + (size_t)(m - NPR) * DM), nullptr, INP(I_NF1), XN + (size_t)m * DM, lane);
        if (BOTH(0)) GRID_BAR();
    }
    if (IN(1)) {
        pg8::Gemm g{XN, W13A, MR, 2 * DFF, DM}; pg8::StaticOrder S; S.init(MR, 2 * DFF, DM, G, bx);
        pg8::EpiSwiGLU E{HB, DFF};
        pg8::gemm_phase<pg8::EpiSwiGLU, pg8::StaticOrder, GEMM_ALIGN, GEMM_SP2>(lds + RING_OFF, g, S, E);
        TAIL_CONVERT(S.nwg, INP(I_W2A), DM, DFF, W2A);
        if (BOTH(1)) GRID_BAR();
    }
    if (IN(2)) {
#if P2_HOSTS_CONVERSION
        pg8::Gemm g{HB, W2A, MR, DM, DFF}; pg8::StaticOrder S; S.init(MR, DM, DFF, G, bx);
        pg8::EpiRes E{INP(I_XP), INP(I_XS) - (size_t)NPR * DM, NPR / 256, Y, DM, 0.5f, S2 - (size_t)NPR * DM};
        pg8::gemm_phase<pg8::EpiRes, pg8::StaticOrder, GEMM_ALIGN, GEMM_SP2>(lds + RING_OFF, g, S, E);
        { const int extra = S.nwg % G;
#if defined(P2CONV_ONLY_W13B)
          if (bx >= extra) CONVERT_RANGE(2 * CV_I_FF, 4 * CV_I_FF, (bx - extra) * NWAVES + wave, (G - extra) * NWAVES); }
#else
          if (bx >= extra) CONVERT_RANGE(2 * CV_I_FF, CV_NITEMS, (bx - extra) * NWAVES + wave, (G - extra) * NWAVES); }
#endif
#else
        pg8::Gemm g{HB, W2A, MR, DM, DFF}; pg8::SplitOrder S; S.init(MR, NPR, DM, DFF, G, bx);
        pg8::EpiRes E{INP(I_XP), INP(I_XS) - (size_t)NPR * DM, NPR / 256, Y, DM, 0.5f, S2 - (size_t)NPR * DM};
        pg8::gemm_phase<pg8::EpiRes, pg8::SplitOrder, GEMM_ALIGN, GEMM_SP2>(lds + RING_OFF, g, S, E);
#endif
        if (BOTH(2)) GRID_BAR();
    }
    if (IN(3)) {
        for (int m = W.gw; m < MR; m += W.ngw) rms_row_4096(Y + (size_t)m * DM, (!P2_HOSTS_CONVERSION && m >= NPR) ? S2 + (size_t)(m - NPR) * DM : nullptr, INP(I_NMIX), XN + (size_t)m * DM, lane);
        if (BOTH(3)) GRID_BAR();
    }
    if (IN(4)) {
        pg8::Gemm g{XN, WINT, MR, 8192, DM}; pg8::StaticOrder S; S.init(MR, 8192, DM, G, bx); S.pshuf = P4_PSHUF;
        pg8::EpiWin E{QNB, out + O_KP, out + O_VP, UU, KBP, VBP, INP(I_QN), INP(I_KN), (LAS float*)(lds + QKTAB_OFF), NPR / 256,
                       (long)O_KS - (long)O_KP - (long)NPR * DA, (long)O_VS - (long)O_VP - (long)NPR * DA};
#if defined(PROBE_NULL_EPI)
        if (sub == 1) { pg8::EpiNull EN; pg8::gemm_phase<pg8::EpiNull, pg8::StaticOrder, GEMM_ALIGN, GEMM_SP2>(lds + RING_OFF, g, S, EN); } else
        if (sub == 2) { pg8::EpiNull EN; pg8::SameOrder SS{10}; pg8::gemm_phase<pg8::EpiNull, pg8::SameOrder, GEMM_ALIGN, GEMM_SP2>(lds + RING_OFF, g, SS, EN); } else
#endif
        pg8::gemm_phase<pg8::EpiWin, pg8::StaticOrder, GEMM_ALIGN, GEMM_SP2>(lds + RING_OFF, g, S, E);
        if (BOTH(4)) GRID_BAR();
    }
    if (IN(5)) {
        if (sub & 1) { const float* bfv = INP(I_BF);
          LAS f32x4* red = (LAS f32x4*)(lds + RING_OFF);
          const int hw = wave >> 2, kq4 = wave & 3;
          for (int t0 = 2 * vcu; t0 < MR / 16; t0 += 2 * G) { const int task = t0 + hw, row0 = 16 * task; f32x4 acc = {0.f, 0.f, 0.f, 0.f};
              const bf16* ap = XN + (size_t)(row0 + (lane & 15)) * DM + 1024 * kq4 + 8 * (lane >> 4); const bf16* bp = WFT + (size_t)(lane & 15) * DM + 1024 * kq4 + 8 * (lane >> 4);
#pragma unroll 8
              for (int kk = 0; kk < 32; ++kk) acc = __builtin_amdgcn_mfma_f32_16x16x32_bf16(*(const bf16x8*)(ap + 32 * kk), *(const bf16x8*)(bp + 32 * kk), acc, 0, 0, 0);
              __builtin_amdgcn_sched_barrier(0);
              red[(hw * 4 + kq4) * 64 + lane] = acc;
              LDS_WAIT(); __builtin_amdgcn_sched_barrier(0);
              __syncthreads();
              if (kq4 == 0) { const f32x4 s4 = (red[(hw * 4 + 0) * 64 + lane] + red[(hw * 4 + 1) * 64 + lane]) + (red[(hw * 4 + 2) * 64 + lane] + red[(hw * 4 + 3) * 64 + lane]);
                  const int h = lane & 15; const float bias = bfv[h];
                  f32x4 lf4;
#pragma unroll
                  for (int j = 0; j < 4; ++j) { const int r = row0 + 4 * (lane >> 4) + j; const float lf = log_sigmoid(s4[j] + bias); lf4[j] = lf;
                      if (r < NPR) out[O_LP + (size_t)r * NH + h] = lf; else out[O_LS + (size_t)(r - NPR) * NH + h] = lf; }
                  { const int r0 = row0 + 4 * (lane >> 4); if (r0 < NPR) *(f32x4*)(FQP + ((size_t)((r0 >> 12) * NH + h)) * SEQ + (r0 & (SEQ - 1))) = lf4; } }
              __syncthreads(); } }
        if (sub & 4) { LAS float* bu_l = (LAS float*)(lds + RING_OFF + wave * 12800); LAS bf16* xt_l = (LAS bf16*)(lds + RING_OFF + wave * 12800 + 8192);
          for (int task = W.gw; task < 128 * NG; task += W.ngw) { const int sc = task / NG, g = task % NG; float xr = 0.f, xi = 0.f;
              ssm_chunk<false>(UU, (sc / 64) * SEQ + (sc % 64) * 64, g, LAMB, BB, CC, INP(I_DSK), YS, xr, xi, bu_l, xt_l, lane);
              SLOC[((size_t)task * NP + lane) * 2] = xr; SLOC[((size_t)task * NP + lane) * 2 + 1] = xi; } }
        if (BOTH(5)) GRID_BAR();
    }
    if (IN(6)) {
        constexpr float RS = 11.313708498984761f;
        for (int task = W.gw; task < NBP * NH + NBS * NH; task += W.ngw) {
            if (task < NBP * NH) {
                const float* src = FQP + (size_t)task * SEQ + lane; float* nf = NFP + (size_t)task * SEQ + lane; float v[64];
#pragma unroll
                for (int c = 0; c < 64; ++c) v[c] = src[64 * c];
                float carry = 0.f;
#pragma unroll
                for (int c = 0; c < 64; ++c) { float incl = v[c];
#pragma unroll
                    for (int o = 1; o < 64; o <<= 1) { const float t = __shfl_up(incl, o); if (lane >= o) incl += t; }
                    nf[64 * c] = (carry + incl) * (-RS); carry += __shfl(incl, 63); } }
            else { const int u = task - NBP * NH, b = u / NH, h = u % NH;
                float incl = out[O_LS + ((size_t)b * TS + lane) * NH + h];
#pragma unroll
                for (int o = 1; o < 64; o <<= 1) { const float t = __shfl_up(incl, o); if (lane >= o) incl += t; }
                NFS[(size_t)u * SKVS + PAST + lane] = (FQS[(size_t)u * TS] + incl) * (-RS); }
        }
        for (int task = W.gw; task < NBP * NG; task += W.ngw) { const int b = task / NG, g = task % NG; typedef float f32x2 __attribute__((ext_vector_type(2)));
            const f32x2 l64 = *(const f32x2*)(LAM64 + (g * NP + lane) * 2); float xr = 0.f, xi = 0.f;
#pragma unroll 8
            for (int c = 0; c < 64; ++c) { const size_t idx = (((size_t)(b * 64 + c) * NG + g) * NP + lane) * 2; *(f32x2*)(XIN + idx) = (f32x2){xr, xi}; const f32x2 s = *(const f32x2*)(SLOC + idx);
                const float nxr = fmaf(l64.x, xr, fmaf(-l64.y, xi, s.x)), nxi = fmaf(l64.x, xi, fmaf(l64.y, xr, s.y)); xr = nxr; xi = nxi; }
            out[O_SRP + (size_t)task * NP + lane] = xr; out[O_SIP + (size_t)task * NP + lane] = xi; }
        if (BOTH(6)) GRID_BAR();
    }
    if (IN(7)) {
        {
          float Dskip; { const float* gqp = INP(I_QN); const float* gkp = INP(I_KN); float mq = fmaxf(fabsf(gqp[lane]), fabsf(gqp[lane + 64])), mk = fmaxf(fabsf(gkp[lane]), fabsf(gkp[lane + 64]));
#pragma unroll
              for (int o = 1; o < 64; o <<= 1) { mq = fmaxf(mq, __shfl_xor(mq, o)); mk = fmaxf(mk, __shfl_xor(mk, o)); }
              Dskip = 256.0f * mq * mk + 110.0f * 11.313708498984761f; }
#if defined(ATTN_NO_SKIP)
          Dskip = 3.0e38f;
#endif
          auto sec_prompt = [&]() __attribute__((always_inline)) {
          if (sub & 1) { typedef att::BlockRef<att::bf16> BR; att::Seam<att::bf16> S; const att::KVBase kvb{(const char*)ws, (const char*)ws, (const char*)ws};
#define MKREF(r, L_, pass_) do { const int L__ = (L_); const int bh = L__ >> 3, x = L__ & 7, qb = (pass_) ? 15 - x : x, b = bh >> 4, h = bh & 15; const unsigned r0 = (unsigned)b * SEQ, rq = r0 + (unsigned)qb * 256; \
              (r).q = (unsigned)WS_QN + (rq * DA + h * HD) * 2u; (r).k = (unsigned)WS_KBP + (r0 * DA + h * HD) * 2u; (r).v = (unsigned)WS_VBP + (r0 * DA + h * HD) * 2u; (r).k2 = (r).k; (r).v2 = (r).v; \
              (r).nf = (unsigned)WS_NFP + (unsigned)bh * SEQ * 4u; (r).o = (unsigned)WS_OB + (rq * DA + h * HD) * 2u; (r).P0 = qb * 256; (r).skv = SEQ; (r).qrows = 256; (r).split = 1 << 30; } while (0)
            int L = bx;
            if (L < 256) { int pass = 0; BR cur; MKREF(cur, L, 0);
                att::fox_prime<att::bf16>((const char*)ws, kvb, cur, Dskip, (char*)lds_raw + RING_OFF, S);
                for (;;) { const bool more_pass = pass == 0, more_item = L + G < 256, last = !more_pass && !more_item;
                    int passn = pass + 1, Ln = L; if (!more_pass) { passn = 0; Ln = more_item ? L + G : L; }
                    BR nxt = cur; if (!last) MKREF(nxt, Ln, passn);
                    att::fox_block<att::bf16>((const char*)ws, (char*)ws, kvb, cur, nxt, Dskip, (char*)lds_raw + RING_OFF, S);
                    if (last) break;
                    cur = nxt; pass = passn; L = Ln; } }
#undef MKREF
          }
          __syncthreads(); };
          auto sec_sample = [&]() __attribute__((always_inline)) {
          if (sub & 4) { typedef att::BlockRef<float> BR; att::Seam<float> S; const att::KVBase kvb{(const char*)INP(I_CK), (const char*)INP(I_CV), (const char*)out};
#define MKREF(r, U_) do { const int u = (U_), b = u >> 4, h = u & 15; const unsigned rq = (unsigned)NPR + (unsigned)b * TS; \
              (r).q = (unsigned)WS_QN + (rq * DA + h * HD) * 2u; (r).k = ((unsigned)b * PAST * DA + h * HD) * 4u; (r).v = (r).k; \
              (r).k2 = (unsigned)((O_KS + ((size_t)b * TS) * DA + h * HD - (size_t)PAST * DA) * 4); (r).v2 = (unsigned)((O_VS + ((size_t)b * TS) * DA + h * HD - (size_t)PAST * DA) * 4); \
              (r).nf = (unsigned)WS_NFS + (unsigned)u * SKVS * 4u; (r).o = (unsigned)WS_OB + (rq * DA + h * HD) * 2u; (r).P0 = PAST; (r).skv = SKVS; (r).qrows = TS; (r).split = PAST; } while (0)
            int U = bx;
            if (U < NBS * NH) { BR cur; MKREF(cur, U);
                att::fox_prime<float>((const char*)ws, kvb, cur, Dskip, (char*)lds_raw + RING_OFF, S);
                for (;;) { const bool last = U + G >= NBS * NH;
                    BR nxt = cur; if (!last) MKREF(nxt, U + G);
                    att::fox_block<float>((const char*)ws, (char*)ws, kvb, cur, nxt, Dskip, (char*)lds_raw + RING_OFF, S);
                    if (last) break;
                    cur = nxt; U += G; } }
#undef MKREF
          }
          __syncthreads(); };
          auto sec_ssm = [&]() __attribute__((always_inline)) {
        if (sub & 2) { LAS float* bu_l = (LAS float*)(lds + RING_OFF + wave * 12800); LAS bf16* xt_l = (LAS bf16*)(lds + RING_OFF + wave * 12800 + 8192);
          for (int task = W.gw; task < (128 + NBS) * NG; task += W.ngw) { const int sc = task / NG, g = task % NG; float xr, xi; int row0;
              if (sc < 128) { row0 = (sc / 64) * SEQ + (sc % 64) * 64; xr = XIN[((size_t)task * NP + lane) * 2]; xi = XIN[((size_t)task * NP + lane) * 2 + 1]; }
              else { const int b = sc - 128; row0 = NPR + b * TS; xr = INP(I_SRE)[((size_t)b * NG + g) * NP + lane]; xi = INP(I_SIM)[((size_t)b * NG + g) * NP + lane]; }
#if defined(DBG_SSM_NOFULL)
              ssm_chunk<false>(UU, row0, g, LAMB, BB, CC, INP(I_DSK), YS, xr, xi, bu_l, xt_l, lane);
#else
              ssm_chunk<true>(UU, row0, g, LAMB, BB, CC, INP(I_DSK), YS, xr, xi, bu_l, xt_l, lane);
#endif
#if defined(DBG_NO_STATE_STORE)
              asm volatile("" :: "v"(xr), "v"(xi));
#else
              if (sc >= 128) { const int b = sc - 128; out[O_SRS + ((size_t)b * NG + g) * NP + lane] = xr; out[O_SIS + ((size_t)b * NG + g) * NP + lane] = xi; }
#endif
          } }
          __syncthreads(); };
#if P7_ROTATE == 3
          const int rot = bx % 3;
          if (rot == 2) sec_ssm();
          if (rot != 1) sec_prompt();
          sec_sample();
          if (rot != 2) sec_ssm();
          if (rot == 1) sec_prompt();
#elif P7_ROTATE == 2
          const int rot = bx & 1;
          if (rot == 0) sec_sample();
          sec_prompt(); sec_ssm();
          if (rot == 1) sec_sample();
#else
          sec_prompt(); sec_sample(); sec_ssm();
#endif
        }
        if (BOTH(7)) GRID_BAR();
    }
    auto merge_half = [&](int row, int half) __attribute__((always_inline)) {
            const bf16* src = (half ? YG : OB) + (size_t)row * DA; const float* gain = INP(half ? I_ONS : I_ONA); bf16* dst = XN + (size_t)row * DM + half * DA;
            v4u v[4]; float s = 0.f;
#pragma unroll
            for (int j = 0; j < 4; ++j) { v[j] = *(const v4u*)(src + 8 * (lane + 64 * j));
                const float a0 = bf_lo(v[j].x), a1 = bf_hi(v[j].x), a2 = bf_lo(v[j].y), a3 = bf_hi(v[j].y), a4 = bf_lo(v[j].z), a5 = bf_hi(v[j].z), a6 = bf_lo(v[j].w), a7 = bf_hi(v[j].w);
                s += ((a0 * a0 + a1 * a1) + (a2 * a2 + a3 * a3)) + ((a4 * a4 + a5 * a5) + (a6 * a6 + a7 * a7)); }
            const float r = rsqrtf(wave_sum(s) * (1.f / 2048.f) + EPS);
#pragma unroll
            for (int j = 0; j < 4; ++j) { const f32x4 g0 = *(const f32x4*)(gain + 8 * (lane + 64 * j)), g1 = *(const f32x4*)(gain + 8 * (lane + 64 * j) + 4); v4u w;
                w.x = pk2(bf_lo(v[j].x) * r * g0.x, bf_hi(v[j].x) * r * g0.y); w.y = pk2(bf_lo(v[j].y) * r * g0.z, bf_hi(v[j].y) * r * g0.w);
                w.z = pk2(bf_lo(v[j].z) * r * g1.x, bf_hi(v[j].z) * r * g1.y); w.w = pk2(bf_lo(v[j].w) * r * g1.z, bf_hi(v[j].w) * r * g1.w);
                *(v4u*)(dst + 8 * (lane + 64 * j)) = w; } };
    if (IN(8)) {
        pg8::Gemm g{YS, WGLUT, MR, DS, DS}; pg8::StaticOrder S; S.init(MR, DS, DS, G, bx);
        pg8::EpiGLU E{YS, YG, DS};
        pg8::gemm_phase<pg8::EpiGLU, pg8::StaticOrder, GEMM_ALIGN, GEMM_SP2>(lds + RING_OFF, g, S, E);
        TAIL_CONVERT(S.nwg, INP(I_WOUT), DM, DM, WOUTT);
#if P8_HOSTS_OB_NORM
        { const int extra = S.nwg % G; if (bx >= extra) for (int row = (bx - extra) * NWAVES + wave; row < MR; row += (G - extra) * NWAVES) merge_half(row, 0); }
#endif
        if (BOTH(8)) GRID_BAR();
    }
    if (IN(9)) {
#if P8_HOSTS_OB_NORM
        for (int row = W.gw; row < MR; row += W.ngw) merge_half(row, 1);
#else
        for (int task = W.gw; task < 2 * MR; task += W.ngw) merge_half(task >> 1, task & 1);
#endif
        if (BOTH(9)) GRID_BAR();
    }
    if (IN(10)) {
        pg8::Gemm g{XN, WOUTT, MR, DM, DM}; pg8::SplitOrder S; S.init(MR, NPR, DM, DM, G, bx);
        pg8::EpiRes E{Y, Y, 1 << 30, Y, DM, 1.0f, S2 - (size_t)NPR * DM};
        pg8::gemm_phase<pg8::EpiRes, pg8::SplitOrder, GEMM_ALIGN, GEMM_SP2>(lds + RING_OFF, g, S, E);
        if (BOTH(10)) GRID_BAR();
    }
    if (IN(11)) {
        for (int m = W.gw; m < MR; m += W.ngw) rms_row_4096(Y + (size_t)m * DM, m >= NPR ? S2 + (size_t)(m - NPR) * DM : nullptr, INP(I_NF2), XN + (size_t)m * DM, lane);
        if (BOTH(11)) GRID_BAR();
    }
    if (IN(12)) {
        pg8::Gemm g{XN, W13B, MR, 2 * DFF, DM}; pg8::StaticOrder S; S.init(MR, 2 * DFF, DM, G, bx);
        pg8::EpiSwiGLU E{HB, DFF};
        pg8::gemm_phase<pg8::EpiSwiGLU, pg8::StaticOrder, GEMM_ALIGN, GEMM_SP2>(lds + RING_OFF, g, S, E);
        TAIL_CONVERT(S.nwg, INP(I_W2B), DM, DFF, W2B);
        if (BOTH(12)) GRID_BAR();
    }
    if (IN(13)) {
        pg8::Gemm g{HB, W2B, MR, DM, DFF}; pg8::SplitOrder S; S.init(MR, NPR, DM, DFF, G, bx);
        pg8::EpiRes E{Y, Y, 1 << 30, Y, DM, 0.5f, S2 - (size_t)NPR * DM};
        pg8::gemm_phase<pg8::EpiRes, pg8::SplitOrder, GEMM_ALIGN, GEMM_SP2>(lds + RING_OFF, g, S, E);
        if (BOTH(13)) GRID_BAR();
    }
    if (IN(14)) {
        for (size_t i = (size_t)W.gw * 64 + lane; i < (size_t)NSR * DM / 4; i += (size_t)W.ngw * 64) { GAS f32x4* yp = (GAS f32x4*)(Y + (size_t)NPR * DM) + i; *yp = *yp + ((const GAS f32x4*)S2)[i]; }
    }
#undef IN
#undef BOTH
}

#if defined(DBG_STOP_AFTER)
__global__ void dbg_fill(float* out) { for (size_t i = (size_t)blockIdx.x * blockDim.x + threadIdx.x; i < O_END / 4; i += (size_t)gridDim.x * blockDim.x) ((f32x4*)out)[i] = (f32x4){0.f, 0.f, 0.f, 0.f}; }
#endif
extern "C" void kernel_launch(void* const* d_in, const int* in_sizes, int n_in, void* d_out, int out_size, void* d_ws, size_t ws_size, hipStream_t stream) {
    static int grid = 0;
    if (grid == 0) {
        if (n_in != 32 || out_size != (int)O_END || ws_size < WS_END) { fprintf(stderr, "kernel_launch: unexpected problem (n_in %d, out %d, ws %zu; want 32, %zu, >= %zu); nothing launched\n", n_in, out_size, ws_size, (size_t)O_END, (size_t)WS_END); grid = -1; return; }
        int dev = 0, cus = 0, per_cu = 0;
        if (hipGetDevice(&dev) != hipSuccess || hipDeviceGetAttribute(&cus, hipDeviceAttributeMultiprocessorCount, dev) != hipSuccess) { fprintf(stderr, "kernel_launch: device query failed\n"); grid = -1; return; }
        if (hipFuncSetAttribute((const void*)fwd_kernel, hipFuncAttributeMaxDynamicSharedMemorySize, LDS_BYTES) != hipSuccess) { fprintf(stderr, "kernel_launch: hipFuncSetAttribute failed\n"); grid = -1; return; }
        if (hipOccupancyMaxActiveBlocksPerMultiprocessor(&per_cu, (const void*)fwd_kernel, NWAVES * 64, LDS_BYTES) != hipSuccess || per_cu < 1) { fprintf(stderr, "kernel_launch: occupancy query says %d blocks per CU\n", per_cu); }
        (void)hipGetLastError();
        grid = cus;
    }
    if (grid < 0) return;
    (void)hipMemsetAsync((char*)d_ws + WS_CTL, 0, CTL_ZERO_BYTES, stream);
    Args a{};
    for (int i = 0; i < 32; ++i) a.in[i] = (const float*)d_in[i];
    a.out = (float*)d_out; a.ws = (unsigned char*)d_ws; a.sub = 7;
#if MK_ONE_LAUNCH
    a.ph_lo = 0; a.ph_hi = N_PHASES;
    hipLaunchKernelGGL(fwd_kernel, dim3(grid), dim3(NWAVES * 64), LDS_BYTES, stream, a);
#else
#if defined(DBG_STOP_AFTER)
    hipLaunchKernelGGL(dbg_fill, dim3(1024), dim3(256), 0, stream, (float*)d_out);
#define DBG_LAST (DBG_STOP_AFTER)
#else
#define DBG_LAST (N_PHASES - 1)
#endif
#ifndef REP_MASK
#define REP_MASK 0u
#endif
#ifndef REP_SUB
#define REP_SUB 7
#endif
    for (int p = 0; p <= DBG_LAST; ++p) { a.ph_lo = p; a.ph_hi = p + 1;
        for (int r = 0; r < 1 + (int)(((unsigned)(REP_MASK) >> p) & 1u); ++r) { a.sub = r == 0 ? 7 : REP_SUB; hipLaunchKernelGGL(fwd_kernel, dim3(grid), dim3(NWAVES * 64), LDS_BYTES, stream, a); } }
#endif
    const hipError_t le = hipPeekAtLastError();
    if (le != hipSuccess) fprintf(stderr, "kernel_launch: launch failed: %s\n", hipGetErrorName(le));
}
```

```cpp
#include <hip/hip_runtime.h>
#include <cstdio>
#include <cstdint>
namespace pg8 {
#define PG8_LAS __attribute__((address_space(3)))
typedef unsigned short bf16_t;
typedef short bf16x8 __attribute__((ext_vector_type(8)));
typedef float f32x4 __attribute__((ext_vector_type(4)));
typedef unsigned u32x4 __attribute__((ext_vector_type(4)));
constexpr int BM = 256, BK = 64, HALF = 128, HTB = HALF * BK * 2  , STAGE_BYTES = 8 * HTB, NXCD = 8;

__host__ __device__ __forceinline__ int lds_byte(int r, int c) { const int st = (r >> 4) * 2 + (c >> 5), rr = r & 15, cc = c & 31, ob = rr * 64 + cc * 2; return st * 1024 + (ob ^ (((ob >> 9) & 1) << 5)); }
__host__ __device__ __forceinline__ void stage_rc(int b, int& R, int& C) { const int st = b / 1024, sb = b % 1024, swz = sb ^ (((sb >> 9) & 1) << 5); R = (st >> 1) * 16 + swz / 64; C = (st & 1) * 32 + (swz % 64) / 2; }
__host__ __device__ __forceinline__ int perm32(int rho) { const int n = rho >> 4, i = rho & 15; return 8 * (i >> 2) + 4 * n + (i & 3); }

struct Unit { int pm, pn, kt0, nkt, part; };
struct Gemm { const bf16_t* A; const bf16_t* Bt; int M, N, K; };

struct StaticOrder {
    int nM, nN, nwg, G, c, nt, WGM, pshuf = 0;
    __host__ __device__ void init(int M, int N, int K, int G_, int c_) { nM = M / BM; nN = N / BM; nwg = nM * nN; G = G_; c = c_; nt = K / BK; WGM = (nM % NXCD == 0) ? nM / NXCD : 8; }
    __host__ __device__ __forceinline__ bool next(int i, Unit& u) const {
        const long L = (long)i * G + c; const bool ok = L < nwg;
        int wgid = ok ? (int)L : 0; { const int q = nwg / NXCD, r = nwg % NXCD, xcd = wgid % NXCD, off = wgid / NXCD; wgid = (xcd < r ? xcd * (q + 1) : r * (q + 1) + (xcd - r) * q) + off; }
        const int nig = WGM * nN, gid = wgid / nig, fm = gid * WGM, gsz = (nM - fm) < WGM ? (nM - fm) : WGM;
        const int pn0 = (wgid % nig) / gsz;
        u.pm = fm + ((wgid % nig) % gsz); u.pn = pshuf ? (pn0 & 3) * (nN >> 2) + (pn0 >> 2) : pn0; u.kt0 = 0; u.nkt = nt; u.part = 0; return ok;
    }
    __device__ __forceinline__ void a_ready(const Unit&) const {}
    __device__ __forceinline__ void done(const Unit&) const {}
};
struct SameOrder { int n;
    __host__ __device__ __forceinline__ bool next(int i, Unit& u) const { u.pm = 0; u.pn = 0; u.kt0 = 0; u.nkt = 32; u.part = 0; return i < n; }
    __device__ __forceinline__ void a_ready(const Unit&) const {}
    __device__ __forceinline__ void done(const Unit&) const {}
};
struct SplitOrder {
    StaticOrder so; int nfull, pm0, nN, rem, nt, c;
    __host__ __device__ void init(int M, int Mfull, int N, int K, int G, int c_) { so.init(Mfull, N, K, G, c_); nfull = so.nwg / G; pm0 = Mfull / BM; nN = N / BM; rem = ((M - Mfull) / BM) * nN; nt = K / BK; c = c_; }
    __host__ __device__ __forceinline__ bool next(int i, Unit& u) const {
        const bool full = i < nfull, split = i == nfull && rem > 0;
        Unit a; const bool oka = so.next(full ? i : 0, a);
        const int remc = rem > 0 ? rem : 1, ns = so.G / remc, prows = remc / nN > 0 ? remc / nN : 1, nk = nt / ns;
        int j = c % remc, part = c / remc;
#if !defined(SPLIT_PLAIN)
        { const int cpx = nN * ns / NXCD; if (NXCD % ns == 0 && cpx * NXCD == nN * ns && prows * cpx * NXCD == so.G) { const int xcd = c % NXCD, m = c / NXCD; part = xcd % ns; j = ((xcd / ns) * cpx + m / prows) * prows + m % prows; } }
#endif
        u.pm = full ? a.pm : pm0 + j % prows; u.pn = full ? a.pn : j / prows; u.part = full ? 0 : part; u.nkt = full ? nt : nk; u.kt0 = full ? 0 : part * nk;
        return full ? oka : split;
    }
    __device__ __forceinline__ void a_ready(const Unit&) const {}
    __device__ __forceinline__ void done(const Unit&) const {}
};

__device__ __forceinline__ unsigned cvt_pk_bf16(float lo, float hi) { unsigned r; asm volatile("v_cvt_pk_bf16_f32 %0, %1, %2" : "=v"(r) : "v"(lo), "v"(hi)); return r; }
typedef float f32x2 __attribute__((ext_vector_type(2)));

typedef unsigned u32x2 __attribute__((ext_vector_type(2)));
__device__ __forceinline__ float fast_sigmoid(float x) { return __builtin_amdgcn_rcpf(1.0f + __builtin_amdgcn_exp2f(-1.4426950408889634f * x)); }
typedef float f32x2v __attribute__((ext_vector_type(2)));
__device__ __forceinline__ f32x2v swiglu2(f32x2v g, f32x2v u) { const f32x2v t = g * (f32x2v){-1.4426950408889634f, -1.4426950408889634f};
    const f32x2v d = (f32x2v){__builtin_amdgcn_exp2f(t.x), __builtin_amdgcn_exp2f(t.y)} + (f32x2v){1.0f, 1.0f};
    return (g * u) * (f32x2v){__builtin_amdgcn_rcpf(d.x), __builtin_amdgcn_rcpf(d.y)}; }
struct EpiSwiGLU {
    static constexpr bool PERM = true, AFTER_DRAIN = false;
    bf16_t* Hh; int ldh;
    __device__ __forceinline__ void operator()(const f32x4 (&acc)[2][2][4][2], const Unit& u, int wr, int wc, int fr, int fq) const {
        const int row0 = u.pm * BM + wr * 64 + fr, col0 = u.pn * HALF + wc * 32 + 8 * fq;
#pragma unroll
        for (int ai = 0; ai < 2; ++ai)
#pragma unroll
            for (int m = 0; m < 4; ++m) { bf16_t* rowp = Hh + (size_t)(row0 + ai * HALF + m * 16) * ldh + col0;
                const f32x4 g0 = acc[ai][0][m][0], g1 = acc[ai][0][m][1], u0 = acc[ai][1][m][0], u1 = acc[ai][1][m][1];
                const f32x2v p0 = swiglu2((f32x2v){g0[0], g0[1]}, (f32x2v){u0[0], u0[1]}), p1 = swiglu2((f32x2v){g0[2], g0[3]}, (f32x2v){u0[2], u0[3]}),
                             p2 = swiglu2((f32x2v){g1[0], g1[1]}, (f32x2v){u1[0], u1[1]}), p3 = swiglu2((f32x2v){g1[2], g1[3]}, (f32x2v){u1[2], u1[3]});
                u32x4 w; w.x = cvt_pk_bf16(p0.x, p0.y); w.y = cvt_pk_bf16(p1.x, p1.y); w.z = cvt_pk_bf16(p2.x, p2.y); w.w = cvt_pk_bf16(p3.x, p3.y);
                *(u32x4*)rowp = w; }
    }
};
struct EpiRes {
    static constexpr bool PERM = false, AFTER_DRAIN = false;
    const float* base; const float* base2; int pm_split; float* out; int ldc; float s; float* part_out;
    __device__ __forceinline__ void operator()(const f32x4 (&acc)[2][2][4][2], const Unit& u, int wr, int wc, int fr, int fq) const {
        const int row0 = u.pm * BM + wr * 64 + fr, col0 = u.pn * BM + wc * 32 + 4 * fq;
        if (u.part != 0) {
#pragma unroll
            for (int ai = 0; ai < 2; ++ai)
#pragma unroll
                for (int m = 0; m < 4; ++m) { float* rowp = part_out + (size_t)(row0 + ai * HALF + m * 16) * ldc + col0;
#pragma unroll
                    for (int bj = 0; bj < 2; ++bj)
#pragma unroll
                        for (int n = 0; n < 2; ++n) *(f32x4*)(rowp + bj * HALF + n * 16) = acc[ai][bj][m][n] * s; }
            return; }
        const float* bs = u.pm >= pm_split ? base2 : base;
#pragma unroll
        for (int ai = 0; ai < 2; ++ai) { f32x4 b[4][2][2];
#pragma unroll
            for (int m = 0; m < 4; ++m) { const size_t off = (size_t)(row0 + ai * HALF + m * 16) * ldc + col0;
#pragma unroll
                for (int bj = 0; bj < 2; ++bj)
#pragma unroll
                    for (int n = 0; n < 2; ++n) b[m][bj][n] = *(const f32x4*)(bs + off + bj * HALF + n * 16); }
            asm volatile("" ::: "memory");
#pragma unroll
            for (int m = 0; m < 4; ++m) { const size_t off = (size_t)(row0 + ai * HALF + m * 16) * ldc + col0;
#pragma unroll
                for (int bj = 0; bj < 2; ++bj)
#pragma unroll
                    for (int n = 0; n < 2; ++n) *(f32x4*)(out + off + bj * HALF + n * 16) = b[m][bj][n] + acc[ai][bj][m][n] * s; }
            asm volatile("" ::: "memory"); }
    }
};
#ifndef KVB_IN_P5
#define KVB_IN_P5 1
#endif
struct EpiWin {
    static constexpr bool PERM = false, AFTER_DRAIN = false;
    bf16_t* qnb; float* kp; float* vp; float* uu; bf16_t* kbp; bf16_t* vbp; const float* gq; const float* gk; PG8_LAS float* tab; int pm_split;
    long dks, dvs;
    __device__ __forceinline__ void operator()(const f32x4 (&acc)[2][2][4][2], const Unit& u, int wr, int wc, int fr, int fq) const {
        const int seg = u.pn >> 3; const bool smp = u.pm >= pm_split;
        const int row0 = u.pm * BM + wr * 64 + fr, col0 = (u.pn & 7) * BM + wc * 32 + 4 * fq;
        if (seg >= 2) {
            float* dst = seg == 2 ? vp + (smp ? dvs : 0l) : uu;
#pragma unroll
            for (int ai = 0; ai < 2; ++ai)
#pragma unroll
                for (int m = 0; m < 4; ++m) { const int row = row0 + ai * HALF + m * 16; float* rowp = dst + (size_t)row * 2048 + col0;
#pragma unroll
                    for (int bj = 0; bj < 2; ++bj)
#pragma unroll
                        for (int n = 0; n < 2; ++n) *(f32x4*)(rowp + bj * HALF + n * 16) = acc[ai][bj][m][n];
                    if (!KVB_IN_P5 && seg == 2 && !smp) { bf16_t* bp = vbp + (size_t)row * 2048 + col0;
#pragma unroll
                        for (int bj = 0; bj < 2; ++bj)
#pragma unroll
                            for (int n = 0; n < 2; ++n) { const f32x4 a = acc[ai][bj][m][n]; u32x2 w; w.x = cvt_pk_bf16(a[0], a[1]); w.y = cvt_pk_bf16(a[2], a[3]); *(u32x2*)(bp + bj * HALF + n * 16) = w; } } }
            return; }
        const int rl0 = wr * 64 + fr;
#pragma unroll
        for (int ai = 0; ai < 2; ++ai)
#pragma unroll
            for (int m = 0; m < 4; ++m)
#pragma unroll
                for (int bj = 0; bj < 2; ++bj) { const f32x4 a = acc[ai][bj][m][0], b = acc[ai][bj][m][1];
                    float ss = ((a[0] * a[0] + a[1] * a[1]) + (a[2] * a[2] + a[3] * a[3])) + ((b[0] * b[0] + b[1] * b[1]) + (b[2] * b[2] + b[3] * b[3]));
                    ss += __shfl_xor(ss, 16); ss += __shfl_xor(ss, 32);
                    if (fq == 0) tab[((rl0 + ai * HALF + m * 16) * 2 + bj) * 4 + wc] = ss; }
        asm volatile("s_waitcnt lgkmcnt(0)" ::: "memory"); __builtin_amdgcn_s_barrier(); asm volatile("" ::: "memory");
        const f32x4 g0q = *(const f32x4*)(gq + wc * 32 + 4 * fq), g1q = *(const f32x4*)(gq + wc * 32 + 16 + 4 * fq), g0k = *(const f32x4*)(gk + wc * 32 + 4 * fq), g1k = *(const f32x4*)(gk + wc * 32 + 16 + 4 * fq);
        const f32x4 g0 = seg == 0 ? g0q : g0k, g1 = seg == 0 ? g1q : g1k;
#pragma unroll
        for (int ai = 0; ai < 2; ++ai)
#pragma unroll
            for (int m = 0; m < 4; ++m) { const int row = row0 + ai * HALF + m * 16;
#pragma unroll
                for (int bj = 0; bj < 2; ++bj) { const f32x4 t = *(const PG8_LAS f32x4*)(tab + ((rl0 + ai * HALF + m * 16) * 2 + bj) * 4);
                    const float r = __builtin_amdgcn_rsqf(((t[0] + t[1]) + (t[2] + t[3])) * (1.0f / 128.0f) + 1e-6f);
                    const f32x4 o0 = acc[ai][bj][m][0] * r * g0, o1 = acc[ai][bj][m][1] * r * g1;
                    u32x2 w0, w1; w0.x = cvt_pk_bf16(o0[0], o0[1]); w0.y = cvt_pk_bf16(o0[2], o0[3]); w1.x = cvt_pk_bf16(o1[0], o1[1]); w1.y = cvt_pk_bf16(o1[2], o1[3]);
                    if (seg == 0) { bf16_t* qp = qnb + (size_t)row * 2048 + col0 + bj * HALF; *(u32x2*)qp = w0; *(u32x2*)(qp + 16) = w1; }
                    else { float* kf = kp + (smp ? dks : 0l) + (size_t)row * 2048 + col0 + bj * HALF; *(f32x4*)kf = o0; *(f32x4*)(kf + 16) = o1;
                           if (!KVB_IN_P5 && !smp) { bf16_t* kb = kbp + (size_t)row * 2048 + col0 + bj * HALF; *(u32x2*)kb = w0; *(u32x2*)(kb + 16) = w1; } } } }
    }
};
struct EpiNull {
    static constexpr bool PERM = false, AFTER_DRAIN = false;
    __device__ __forceinline__ void operator()(const f32x4 (&acc)[2][2][4][2], const Unit& u, int wr, int wc, int fr, int fq) const {
#pragma unroll
        for (int ai = 0; ai < 2; ++ai)
#pragma unroll
            for (int bj = 0; bj < 2; ++bj)
#pragma unroll
                for (int m = 0; m < 4; ++m)
#pragma unroll
                    for (int n = 0; n < 2; ++n) asm volatile("" :: "v"(acc[ai][bj][m][n]));
    }
};
struct EpiGLU {
    static constexpr bool PERM = true, AFTER_DRAIN = false;
    const bf16_t* Y; bf16_t* O; int ldc;
    __device__ __forceinline__ void operator()(const f32x4 (&acc)[2][2][4][2], const Unit& u, int wr, int wc, int fr, int fq) const {
        const int row0 = u.pm * BM + wr * 64 + fr, col0 = u.pn * BM + wc * 32 + 8 * fq;
#pragma unroll
        for (int ai = 0; ai < 2; ++ai) { u32x4 yb[4][2];
#pragma unroll
            for (int m = 0; m < 4; ++m)
#pragma unroll
                for (int bj = 0; bj < 2; ++bj) yb[m][bj] = *(const u32x4*)(Y + (size_t)(row0 + ai * HALF + m * 16) * ldc + col0 + bj * HALF);
            asm volatile("" ::: "memory");
#pragma unroll
            for (int m = 0; m < 4; ++m) { const size_t off = (size_t)(row0 + ai * HALF + m * 16) * ldc + col0;
#pragma unroll
                for (int bj = 0; bj < 2; ++bj) { const u32x4 yv = yb[m][bj]; const f32x4 a0 = acc[ai][bj][m][0], a1 = acc[ai][bj][m][1];
                    float y[8]; y[0] = __uint_as_float(yv.x << 16); y[1] = __uint_as_float(yv.x & 0xffff0000u); y[2] = __uint_as_float(yv.y << 16); y[3] = __uint_as_float(yv.y & 0xffff0000u);
                    y[4] = __uint_as_float(yv.z << 16); y[5] = __uint_as_float(yv.z & 0xffff0000u); y[6] = __uint_as_float(yv.w << 16); y[7] = __uint_as_float(yv.w & 0xffff0000u);
                    float o[8];
#pragma unroll
                    for (int j = 0; j < 4; ++j) { o[j] = y[j] * fast_sigmoid(a0[j]); o[4 + j] = y[4 + j] * fast_sigmoid(a1[j]); }
                    u32x4 w; w.x = cvt_pk_bf16(o[0], o[1]); w.y = cvt_pk_bf16(o[2], o[3]); w.z = cvt_pk_bf16(o[4], o[5]); w.w = cvt_pk_bf16(o[6], o[7]);
                    *(u32x4*)(O + off + bj * HALF) = w; } } }
    }
};

template <class Epi, class Sched, bool ALIGN_EPI = false, bool SP2 = false>
__device__ __forceinline__ void gemm_phase(PG8_LAS unsigned char* lds, const Gemm g, const Sched& S, const Epi& E) {
    const int tid = threadIdx.x, wid = __builtin_amdgcn_readfirstlane(tid >> 6), lane = tid & 63, wr = wid >> 2, wc = wid & 3, fr = lane & 15, fq = lane >> 4;
    const int K = g.K;
    unsigned voffA[2], voffB[2];
#pragma unroll
    for (int i = 0; i < 2; ++i) { int R, C; stage_rc(tid * 16 + i * 8192, R, C); const int Rb = Epi::PERM ? ((R & ~31) + perm32(R & 31)) : R;
        voffA[i] = (unsigned)(R * K + C) * 2u; voffB[i] = (unsigned)(Rb * K + C) * 2u; }
    const size_t kstep = (size_t)(BK * 2);
    const size_t hstep = (size_t)HALF * K * 2;
    const size_t tstep = 2 * hstep;
    const unsigned ldsw = (unsigned)wid * 1024u;
    const int aoff = lds_byte(wr * 64 + fr, fq * 8), boff = lds_byte(wc * 32 + fr, fq * 8);
#define PG8_SA(b, h) (((b) * 2 + (h)) * HTB)
#define PG8_SB(b, h) ((4 + (b) * 2 + (h)) * HTB)
#define PG8_STAGE(bufoff, gbase, voff) do { _Pragma("unroll") for (int _i = 0; _i < 2; ++_i) \
        __builtin_amdgcn_global_load_lds((const unsigned*)((const char*)(gbase) + (voff)[_i]), (PG8_LAS unsigned*)(lds + (bufoff) + ldsw + _i * 8192), 16, 0, 0); } while (0)
#define PG8_LDA(dst, b, h) do { _Pragma("unroll") for (int m = 0; m < 4; ++m) _Pragma("unroll") for (int k = 0; k < 2; ++k) dst[m][k] = *(const PG8_LAS bf16x8*)(lds + PG8_SA(b, h) + aoff + m * 2048 + k * 1024); } while (0)
#define PG8_LDB(dst, b, h) do { _Pragma("unroll") for (int n = 0; n < 2; ++n) _Pragma("unroll") for (int k = 0; k < 2; ++k) dst[n][k] = *(const PG8_LAS bf16x8*)(lds + PG8_SB(b, h) + boff + n * 2048 + k * 1024); } while (0)
#define PG8_MMA(ai, bj, At, Bt) do { __builtin_amdgcn_s_setprio(1); _Pragma("unroll") for (int m = 0; m < 4; ++m) _Pragma("unroll") for (int n = 0; n < 2; ++n) _Pragma("unroll") for (int k = 0; k < 2; ++k) \
        acc[ai][bj][m][n] = __builtin_amdgcn_mfma_f32_16x16x32_bf16(Bt[n][k], At[m][k], acc[ai][bj][m][n], 0, 0, 0); __builtin_amdgcn_s_setprio(0); } while (0)
#define PG8_WAIT_V(n) asm volatile("s_waitcnt vmcnt(" #n ")" ::: "memory")
#define PG8_WAIT_L(n) asm volatile("s_waitcnt lgkmcnt(" #n ")" ::: "memory")
#define PG8_BAR __builtin_amdgcn_s_barrier()
#define PG8_SCHED __builtin_amdgcn_sched_barrier(0)
    Unit cur, nxt; int ui = 0;
    if (!S.next(0, cur)) return;
    f32x4 acc[2][2][4][2];
#pragma unroll
    for (int a = 0; a < 2; ++a)
#pragma unroll
        for (int b = 0; b < 2; ++b)
#pragma unroll
            for (int m = 0; m < 4; ++m)
#pragma unroll
                for (int n = 0; n < 2; ++n) acc[a][b][m][n] = (f32x4){0.f, 0.f, 0.f, 0.f};
    bf16x8 At[4][2], B0[2][2], B1[2][2];
    const char* cA = (const char*)g.A + (size_t)cur.pm * tstep + (size_t)cur.kt0 * kstep; const char* cB = (const char*)g.Bt + (size_t)cur.pn * tstep + (size_t)cur.kt0 * kstep;
    S.a_ready(cur);
    if constexpr (SP2) {
        PG8_STAGE(PG8_SB(0, 0), cB, voffB); PG8_STAGE(PG8_SB(0, 1), cB + hstep, voffB); PG8_STAGE(PG8_SA(0, 0), cA, voffA); PG8_STAGE(PG8_SA(0, 1), cA + hstep, voffA);
        if (wr == 1) PG8_BAR;
        PG8_WAIT_V(2); PG8_BAR;
        PG8_STAGE(PG8_SB(1, 0), cB + kstep, voffB); PG8_STAGE(PG8_SA(1, 0), cA + kstep, voffA); PG8_STAGE(PG8_SB(1, 1), cB + hstep + kstep, voffB);
        PG8_WAIT_V(6); PG8_BAR;
    } else {
        PG8_STAGE(PG8_SB(0, 0), cB, voffB); PG8_STAGE(PG8_SA(0, 0), cA, voffA); PG8_STAGE(PG8_SB(0, 1), cB + hstep, voffB); PG8_STAGE(PG8_SA(0, 1), cA + hstep, voffA);
        if (wr == 1) PG8_BAR;
        PG8_WAIT_V(4); PG8_BAR;
        PG8_STAGE(PG8_SB(1, 0), cB + kstep, voffB); PG8_STAGE(PG8_SA(1, 0), cA + kstep, voffA); PG8_STAGE(PG8_SB(1, 1), cB + hstep + kstep, voffB);
        PG8_WAIT_V(6); PG8_BAR;
    }
    for (;;) {
        const bool has_next = S.next(ui + 1, nxt);
        const char* nA = has_next ? (const char*)g.A + (size_t)nxt.pm * tstep + (size_t)nxt.kt0 * kstep : cA; const char* nB = has_next ? (const char*)g.Bt + (size_t)nxt.pn * tstep + (size_t)nxt.kt0 * kstep : cB;
        const int nt = cur.nkt;
        for (int t = 0; t < nt; t += 2) {
            const bool last = (t == nt - 2);
            const char* a1 = cA + (size_t)(t + 1) * kstep;
            const char* a2 = last ? nA : cA + (size_t)(t + 2) * kstep; const char* b2 = last ? nB : cB + (size_t)(t + 2) * kstep;
            const char* a3 = a2 + kstep; const char* b3 = b2 + kstep;
            if (last && has_next) S.a_ready(nxt);
            if constexpr (SP2) {
            PG8_LDB(B0, 0, 0); PG8_LDB(B1, 0, 1); PG8_SCHED; PG8_LDA(At, 0, 0); PG8_STAGE(PG8_SA(1, 1), a1 + hstep, voffA);
            PG8_WAIT_V(8); PG8_WAIT_L(0); PG8_BAR; PG8_MMA(0, 0, At, B0); PG8_MMA(0, 1, At, B1); PG8_BAR; PG8_SCHED;
            PG8_LDA(At, 0, 1); PG8_STAGE(PG8_SB(0, 0), b2, voffB); PG8_STAGE(PG8_SB(0, 1), b2 + hstep, voffB); PG8_STAGE(PG8_SA(0, 0), a2, voffA);
            PG8_WAIT_V(8); PG8_WAIT_L(0); PG8_BAR; PG8_MMA(1, 0, At, B0); PG8_MMA(1, 1, At, B1); PG8_BAR; PG8_SCHED;
            PG8_LDB(B0, 1, 0); PG8_LDB(B1, 1, 1); PG8_SCHED; PG8_LDA(At, 1, 0); PG8_STAGE(PG8_SA(0, 1), a2 + hstep, voffA);
            PG8_WAIT_V(8); PG8_WAIT_L(0); PG8_BAR; PG8_MMA(0, 0, At, B0); PG8_MMA(0, 1, At, B1); PG8_BAR; PG8_SCHED;
            PG8_LDA(At, 1, 1); PG8_STAGE(PG8_SB(1, 0), b3, voffB); PG8_STAGE(PG8_SB(1, 1), b3 + hstep, voffB); PG8_STAGE(PG8_SA(1, 0), a3, voffA);
            PG8_WAIT_V(8); PG8_WAIT_L(0); PG8_BAR; PG8_MMA(1, 0, At, B0); PG8_MMA(1, 1, At, B1); PG8_BAR; PG8_SCHED;
            } else {
            PG8_LDB(B0, 0, 0); PG8_SCHED; PG8_LDA(At, 0, 0); PG8_STAGE(PG8_SA(1, 1), a1 + hstep, voffA);
            PG8_WAIT_L(8); PG8_BAR; PG8_WAIT_L(0); PG8_MMA(0, 0, At, B0); PG8_BAR; PG8_SCHED;
            PG8_LDB(B1, 0, 1); PG8_STAGE(PG8_SB(0, 0), b2, voffB);
            PG8_BAR; PG8_WAIT_L(0); PG8_MMA(0, 1, At, B1); PG8_BAR;
            PG8_LDA(At, 0, 1); PG8_STAGE(PG8_SA(0, 0), a2, voffA);
            PG8_BAR; PG8_WAIT_L(0); PG8_MMA(1, 0, At, B0); PG8_BAR; PG8_SCHED;
            PG8_STAGE(PG8_SB(0, 1), b2 + hstep, voffB);
            PG8_WAIT_V(6); PG8_BAR; PG8_MMA(1, 1, At, B1); PG8_BAR;
            PG8_LDB(B0, 1, 0); PG8_SCHED; PG8_LDA(At, 1, 0); PG8_STAGE(PG8_SA(0, 1), a2 + hstep, voffA);
            PG8_WAIT_L(8); PG8_BAR; PG8_WAIT_L(0); PG8_MMA(0, 0, At, B0); PG8_BAR; PG8_SCHED;
            PG8_LDB(B1, 1, 1); PG8_STAGE(PG8_SB(1, 0), b3, voffB);
            PG8_BAR; PG8_WAIT_L(0); PG8_MMA(0, 1, At, B1); PG8_BAR;
            PG8_LDA(At, 1, 1); PG8_STAGE(PG8_SA(1, 0), a3, voffA);
            PG8_BAR; PG8_WAIT_L(0); PG8_MMA(1, 0, At, B0); PG8_BAR; PG8_SCHED;
            PG8_STAGE(PG8_SB(1, 1), b3 + hstep, voffB);
            PG8_WAIT_V(6); PG8_BAR; PG8_MMA(1, 1, At, B1); PG8_BAR;
            }
        }
        if constexpr (ALIGN_EPI) { if (wr == 0) PG8_BAR; }
        if constexpr (!Epi::AFTER_DRAIN) { E(acc, cur, wr, wc, fr, fq); S.done(cur); }
        if (!has_next) break;
#pragma unroll
        for (int a = 0; a < 2; ++a)
#pragma unroll
            for (int b = 0; b < 2; ++b)
#pragma unroll
                for (int m = 0; m < 4; ++m)
#pragma unroll
                    for (int n = 0; n < 2; ++n) acc[a][b][m][n] = (f32x4){0.f, 0.f, 0.f, 0.f};
        cur = nxt; cA = nA; cB = nB; ++ui;
        if constexpr (ALIGN_EPI) { if (wr == 1) PG8_BAR; }
    }
    PG8_WAIT_V(0);
    if constexpr (!ALIGN_EPI) { if (wr == 0) PG8_BAR; }
    PG8_BAR;
    if constexpr (Epi::AFTER_DRAIN) { E.fused(acc, cur, wr, wc, fr, fq, lds, wid, lane); S.done(cur); }
#undef PG8_SA
#undef PG8_SB
#undef PG8_STAGE
#undef PG8_LDA
#undef PG8_LDB
#undef PG8_MMA
#undef PG8_WAIT_V
#undef PG8_WAIT_L
#undef PG8_BAR
#undef PG8_SCHED
}
}

namespace att {
typedef unsigned short bf16;
typedef short bf16x8 __attribute__((ext_vector_type(8)));
typedef short s16x4 __attribute__((ext_vector_type(4)));
typedef float f32x16 __attribute__((ext_vector_type(16)));
typedef float f32x4 __attribute__((ext_vector_type(4)));
typedef unsigned u32x4 __attribute__((ext_vector_type(4)));
constexpr int D = 128, NW = 8, QBLK = 32, KVBLK = 64, QB = NW * QBLK, LD = 2048;
constexpr int SHM_V = KVBLK * D * 2, SHM_K = KVBLK * D * 2;
constexpr int QPMAX = 7;
template <class T> struct QPark { static constexpr int N = 3; };
template <> struct QPark<float> { static constexpr int N = 7; };
constexpr int OFF_WS = 2 * SHM_V + 2 * SHM_K, WS_WAVE = 768, OFF_QP = OFF_WS + NW * WS_WAVE, LDS_BYTES = OFF_QP + QPMAX * 64 * NW * 16;
constexpr float SCALE = 0.08838834764831845f, THR = 8.f, L2E = 1.4426950408889634f;
template <class A, class Bt> struct same_t { static constexpr bool v = false; };
template <class A> struct same_t<A, A> { static constexpr bool v = true; };
#define KSWZ(row, colB) ((row) * 256 + ((colB) ^ (((row) & 7) << 4)))
#define SBAR() __builtin_amdgcn_sched_barrier(0)
__device__ __forceinline__ int v_st(int k, int c) { const int kk = (k & ~0xC) | ((k & 4) << 1) | ((k & 8) >> 1); return ((kk >> 3) * 4 + (c >> 5)) * 512 + ((kk & 7) * 32 + (c & 31)) * 2; }
__device__ __forceinline__ int v_rd_base(int lane) { return ((lane & 3) << 3) | (((lane >> 2) & 3) << 6) | (((lane >> 4) & 1) << 5) | (((lane >> 5) & 1) << 8); }
constexpr int v_rd_off(int d0, int ks, int half) { return d0 * 512 + ks * 4096 + half * 2048; }
__device__ __forceinline__ int crow(int r, int hi) { return (r & 3) + 8 * (r >> 2) + 4 * hi; }
__device__ __forceinline__ unsigned cvtpk(float lo, float hi) { unsigned r; asm volatile("v_cvt_pk_bf16_f32 %0, %1, %2" : "=v"(r) : "v"(lo), "v"(hi)); return r; }
__device__ __forceinline__ bf16x8 pack8(f32x4 a, f32x4 b) { u32x4 w = {cvtpk(a[0], a[1]), cvtpk(a[2], a[3]), cvtpk(b[0], b[1]), cvtpk(b[2], b[3])}; return *reinterpret_cast<bf16x8*>(&w); }
template <class T> __device__ __forceinline__ const __attribute__((address_space(1))) T* uni(const T* p) {
    const unsigned long long v = (unsigned long long)p; const unsigned lo = (unsigned)__builtin_amdgcn_readfirstlane((int)(unsigned)v), hi = (unsigned)__builtin_amdgcn_readfirstlane((int)(unsigned)(v >> 32));
    return (const __attribute__((address_space(1))) T*)(((unsigned long long)hi << 32) | lo);
}
template <class T> __device__ __forceinline__ bf16x8 load8(const __attribute__((address_space(1))) T* p) {
    if constexpr (same_t<T, float>::v) { return pack8(*(const __attribute__((address_space(1))) f32x4*)p, *(const __attribute__((address_space(1))) f32x4*)(p + 4)); }
    else { return *reinterpret_cast<const __attribute__((address_space(1))) bf16x8*>(p); }
}
template <class T> __device__ __forceinline__ bf16x8 load8(const T* p) {
    if constexpr (same_t<T, float>::v) { return pack8(*(const f32x4*)p, *(const f32x4*)(p + 4)); }
    else { return *reinterpret_cast<const bf16x8*>(p); }
}
__device__ __forceinline__ void mask_tile(f32x16& p0, f32x16& p1, int dq) {
    const float NEG = -__builtin_inff();
#pragma unroll
    for (int r = 0; r < 16; ++r) { const int c = (r & 3) + 8 * (r >> 2); if (dq - c < 0) p0[r] = NEG; if (dq - c - 32 < 0) p1[r] = NEG; }
}
__device__ __forceinline__ void partialSM(f32x16& p0, f32x16& p1, float& m_reg, float& mn, float& alpha) {
    float pmax = p0[0];
#pragma unroll
    for (int r = 1; r < 16; ++r) pmax = fmaxf(pmax, p0[r]);
#pragma unroll
    for (int r = 0; r < 16; ++r) pmax = fmaxf(pmax, p1[r]);
    { auto rr = __builtin_amdgcn_permlane32_swap(__float_as_uint(pmax), __float_as_uint(pmax), false, false); pmax = fmaxf(__uint_as_float(rr[0]), __uint_as_float(rr[1])); }
    constexpr float C2 = L2E * SCALE, THR2 = THR * L2E;
    const float pm = pmax * C2;
    if (__builtin_expect(__all(pm - m_reg <= THR2), 1)) { mn = m_reg; alpha = 1.f; }
    else { mn = fmaxf(m_reg, pm); alpha = __builtin_amdgcn_exp2f(m_reg - mn); m_reg = mn; }
    const float mnL = -mn;
#pragma unroll
    for (int r = 0; r < 16; ++r) p0[r] = fmaf(p0[r], C2, mnL);
#pragma unroll
    for (int r = 0; r < 16; ++r) p1[r] = fmaf(p1[r], C2, mnL);
#pragma unroll
    for (int r = 0; r < 16; ++r) p0[r] = __builtin_amdgcn_exp2f(p0[r]);
}
__device__ __forceinline__ void finishSM(f32x16& p0, f32x16& p1, float alpha, float& l_reg, bf16x8& pa0, bf16x8& pa1, bf16x8& pa2, bf16x8& pa3) {
#pragma unroll
    for (int r = 0; r < 16; ++r) p1[r] = __builtin_amdgcn_exp2f(p1[r]);
    float ps = 0;
#pragma unroll
    for (int r = 0; r < 16; ++r) ps += p0[r];
#pragma unroll
    for (int r = 0; r < 16; ++r) ps += p1[r];
    { auto rr = __builtin_amdgcn_permlane32_swap(__float_as_uint(ps), __float_as_uint(ps), false, false); ps = __uint_as_float(rr[0]) + __uint_as_float(rr[1]); }
    l_reg = l_reg * alpha + ps;
#define PK4(P, B_, OUT) do { unsigned a0 = cvtpk(P[B_+0], P[B_+1]), a1 = cvtpk(P[B_+2], P[B_+3]);                          \
        unsigned b0 = cvtpk(P[B_+4], P[B_+5]), b1 = cvtpk(P[B_+6], P[B_+7]);                                             \
        auto r0 = __builtin_amdgcn_permlane32_swap(a0, b0, false, false); auto r1 = __builtin_amdgcn_permlane32_swap(a1, b1, false, false); \
        u32x4 w = {r0[0], r1[0], r0[1], r1[1]}; OUT = *reinterpret_cast<bf16x8*>(&w); } while (0)
    PK4(p0, 0, pa0); PK4(p0, 8, pa1); PK4(p1, 0, pa2); PK4(p1, 8, pa3);
#undef PK4
}
template <int KB, int QP>
__device__ __forceinline__ void qkt(f32x16& p0, f32x16& p1, const char* K_lds, const char* wl, int r32, int hi, const bf16x8* qr, const char* qp) {
#pragma unroll
    for (int g = 0; g < 4; ++g) { const f32x4 a = *reinterpret_cast<const f32x4*>(wl + 256 + KB * 256 + g * 32), b = *reinterpret_cast<const f32x4*>(wl + 256 + KB * 256 + 128 + g * 32);
        p0[4 * g] = a[0]; p0[4 * g + 1] = a[1]; p0[4 * g + 2] = a[2]; p0[4 * g + 3] = a[3]; p1[4 * g] = b[0]; p1[4 * g + 1] = b[1]; p1[4 * g + 2] = b[2]; p1[4 * g + 3] = b[3]; }
    const char* kb[4];
#pragma unroll
    for (int dd = 0; dd < 4; ++dd) kb[dd] = K_lds + KB * SHM_K + KSWZ(r32, (dd * 16 + hi * 8) * 2);
#pragma unroll
    for (int d0 = 0; d0 < 8; ++d0) { const char* a = kb[d0 & 3] + (d0 >> 2) * 128;
        bf16x8 b0 = *reinterpret_cast<const bf16x8*>(a);
        bf16x8 b1 = *reinterpret_cast<const bf16x8*>(a + 32 * 256);
        const bf16x8 q = d0 < 8 - QP ? qr[d0] : *reinterpret_cast<const bf16x8*>(qp + (d0 - (8 - QP)) * (64 * NW * 16));
        p0 = __builtin_amdgcn_mfma_f32_32x32x16_bf16(b0, q, p0, 0, 0, 0);
        p1 = __builtin_amdgcn_mfma_f32_32x32x16_bf16(b1, q, p1, 0, 0, 0); }
}
template <int VB>
__device__ __forceinline__ void pv_tile(f32x16* o, int vb0, bf16x8 pa0, bf16x8 pa1, bf16x8 pa2, bf16x8 pa3) {
#define TRRD(dst, off) asm volatile("ds_read_b64_tr_b16 %0, %1 offset:%2" : "=&v"(dst) : "v"(vb0), "i"(off) : "memory")
#define PV_D0(d0) do { s16x4 l0, l1, l2, l3, h0, h1, h2, h3; constexpr int b_ = VB * SHM_V + v_rd_off(d0, 0, 0);   \
        TRRD(l0, b_); TRRD(h0, b_ + 2048); TRRD(l1, b_ + 4096); TRRD(h1, b_ + 6144); TRRD(l2, b_ + 8192); TRRD(h2, b_ + 10240); TRRD(l3, b_ + 12288); TRRD(h3, b_ + 14336); \
        asm volatile("s_waitcnt lgkmcnt(0)" ::: "memory"); SBAR();   \
        o[d0] = __builtin_amdgcn_mfma_f32_32x32x16_bf16(pa0, (bf16x8){l0[0], l0[1], l0[2], l0[3], h0[0], h0[1], h0[2], h0[3]}, o[d0], 0, 0, 0);   \
        o[d0] = __builtin_amdgcn_mfma_f32_32x32x16_bf16(pa1, (bf16x8){l1[0], l1[1], l1[2], l1[3], h1[0], h1[1], h1[2], h1[3]}, o[d0], 0, 0, 0);   \
        o[d0] = __builtin_amdgcn_mfma_f32_32x32x16_bf16(pa2, (bf16x8){l2[0], l2[1], l2[2], l2[3], h2[0], h2[1], h2[2], h2[3]}, o[d0], 0, 0, 0);   \
        o[d0] = __builtin_amdgcn_mfma_f32_32x32x16_bf16(pa3, (bf16x8){l3[0], l3[1], l3[2], l3[3], h3[0], h3[1], h3[2], h3[3]}, o[d0], 0, 0, 0); } while (0)
    PV_D0(0); PV_D0(1); PV_D0(2); PV_D0(3);
#undef PV_D0
#undef TRRD
}
template <class TIn> struct BlockRef { unsigned q, k, v, k2, v2, nf, o; int P0, skv, qrows, split; };
struct KVBase { const char* k1; const char* v1; const char* kv2; };
#define BQ(ref) ((const bf16*)(wsb + (ref).q))
#define BK(ref) ((const TIn*)(kvb.k1 + (ref).k))
#define BV(ref) ((const TIn*)(kvb.v1 + (ref).v))
#define BNF(ref) ((const float*)(wsb + (ref).nf))
template <class T> struct Stg { bf16x8 v; __device__ __forceinline__ void ld(const __attribute__((address_space(1))) T* p) { v = *reinterpret_cast<const __attribute__((address_space(1))) bf16x8*>(p); } __device__ __forceinline__ bf16x8 get() const { return v; } };
template <> struct Stg<float> { f32x4 a, b; __device__ __forceinline__ void ld(const __attribute__((address_space(1))) float* p) { a = *(const __attribute__((address_space(1))) f32x4*)p; b = *(const __attribute__((address_space(1))) f32x4*)(p + 4); } __device__ __forceinline__ bf16x8 get() const { return pack8(a, b); } };
template <class TIn> struct Seam {
    bf16x8 qr[8];
    Stg<TIn> st_v0, st_v1, st_k0, st_k1;
    float st_nf;
};
#define ROW(p, k0, rr) (uni((p) + (size_t)((k0) + (rr)) * LD) + lane_kv)
#define VMW() asm volatile("s_waitcnt vmcnt(0)" ::: "memory")
#define VMWN(n) asm volatile("s_waitcnt vmcnt(%0)" :: "i"(n) : "memory")
#define SLOAD_H(Kp, Vp, k0) do { S.st_v0.ld(ROW(Vp, k0, 0)); S.st_v1.ld(ROW(Vp, k0, 32)); S.st_k0.ld(ROW(Kp, k0, 0)); S.st_k1.ld(ROW(Kp, k0, 32)); } while (0)
#define SWRITE_HK(bf) do { *(bf16x8*)(K_lds + (bf) * SHM_K + kws) = S.st_k0.get(); *(bf16x8*)(K_lds + (bf) * SHM_K + kws + 32 * 256) = S.st_k1.get(); } while (0)
#define SWRITE_HV(bf) do { *(bf16x8*)(V_lds + (bf) * SHM_V + vst0) = S.st_v0.get(); *(bf16x8*)(V_lds + (bf) * SHM_V + vst1) = S.st_v1.get(); } while (0)
#define NFLOAD(ref, k0) do { S.st_nf = BNF(ref)[(k0) + lane]; } while (0)
#define NFWRITE(bf) do { nf_l[(bf) * 64 + lane] = S.st_nf; } while (0)
#define KSRC(ref, k0) ((k0) >= (ref).split ? (const TIn*)(kvb.kv2 + (ref).k2) : BK(ref))
#define VSRC(ref, k0) ((k0) >= (ref).split ? (const TIn*)(kvb.kv2 + (ref).v2) : BV(ref))
template <class TIn>
__device__ __forceinline__ int fox_jlo(const char* wsb, const BlockRef<TIn>& r, float D, int lane) {
    int j_hi = (r.P0 + QB - 1) / KVBLK + 1; if (j_hi > r.skv / KVBLK) j_hi = r.skv / KVBLK;
    const float* nf = (const float*)(wsb + r.nf);
    const float ref = nf[r.P0] - D; const int j = lane < j_hi ? lane : j_hi - 1;
    const unsigned long long keep = __ballot(nf[KVBLK * j + KVBLK - 1] >= ref);
    int jl = keep ? __builtin_ctzll(keep) : 0; const int jd = r.P0 / KVBLK;
    jl = jl < jd ? jl : jd;
    return __builtin_amdgcn_readfirstlane(jl);
}
template <class TIn>
__device__ __forceinline__ void fox_prime(const char* wsb, const KVBase& kvb, const BlockRef<TIn>& cur, float Dskip, char* lds, Seam<TIn>& S) {
    const int tid = threadIdx.x, wid = __builtin_amdgcn_readfirstlane(tid >> 6), lane = tid & 63, r32 = lane & 31, hi = lane >> 5;
    const int sr = tid >> 4, sc = (tid & 15) * 8, kws = KSWZ(sr, sc * 2); char* K_lds = lds + 2 * SHM_V; float* nf_l = (float*)(lds + OFF_WS + wid * WS_WAVE + 256);
    const unsigned lane_kv = (unsigned)(sr * LD + sc), lane_q = (unsigned)(r32 * LD + hi * 8);
    const int qrow0 = wid * QBLK < cur.qrows ? wid * QBLK : 0;
    for (int d0 = 0; d0 < 8; ++d0) S.qr[d0] = load8<bf16>(uni(BQ(cur) + (size_t)qrow0 * LD + d0 * 16) + lane_q);
    const int kb0 = fox_jlo<TIn>(wsb, cur, Dskip, lane) * KVBLK;
    NFLOAD(cur, kb0);
    SLOAD_H(KSRC(cur, kb0), VSRC(cur, kb0), kb0); VMW(); SWRITE_HK(0); NFWRITE(0);
    __syncthreads();
}
template <class TIn>
__device__ __forceinline__ void fox_block(const char* wsb, char* wsw, const KVBase& kvb, const BlockRef<TIn>& cur, const BlockRef<TIn>& nxt, float Dskip, char* lds, Seam<TIn>& S) {
    constexpr int QP = QPark<TIn>::N;
    const int tid = threadIdx.x, wid = __builtin_amdgcn_readfirstlane(tid >> 6), lane = tid & 63, r32 = lane & 31, hi = lane >> 5;
    int j_hi = (cur.P0 + QB - 1) / KVBLK + 1; if (j_hi > cur.skv / KVBLK) j_hi = cur.skv / KVBLK;
    const int j_lo = fox_jlo<TIn>(wsb, cur, Dskip, lane), NT = j_hi - j_lo;
    const int qlo = cur.P0 + wid * QBLK, qm = qlo + r32 - 4 * hi;
    char* V_lds = lds; char* K_lds = lds + 2 * SHM_V;
    char* wsw_l = lds + OFF_WS + wid * WS_WAVE; float* li_l = (float*)wsw_l, * al_l = (float*)(wsw_l + 128), * nf_l = (float*)(wsw_l + 256);
    const char* wl = wsw_l + hi * 16;
    float m_reg = -1e30f, l_reg = 0; f32x16 o[4] = {};
    const int sr = tid >> 4, sc = (tid & 15) * 8, vst0 = v_st(sr, sc), vst1 = v_st(32 + sr, sc), kws = KSWZ(sr, sc * 2);
    const int vb0 = (int)(uintptr_t)V_lds + v_rd_base(lane);
    const unsigned lane_kv = (unsigned)(sr * LD + sc), lane_q = (unsigned)(r32 * LD + hi * 8);
    const bool wlive = wid * QBLK < cur.qrows;
    char* qp = lds + OFF_QP + tid * 16;
#pragma unroll
    for (int j = 0; j < QP; ++j) *reinterpret_cast<bf16x8*>(qp + j * (64 * NW * 16)) = S.qr[8 - QP + j];
#define RESC(a) do { if (__any((a) < 1.f)) { if (hi == 0) al_l[r32] = (a); asm volatile("s_waitcnt lgkmcnt(0)" ::: "memory");              \
                     for (int d_ = 0; d_ < 4; ++d_) for (int r = 0; r < 16; ++r) o[d_][r] *= *(const float*)(wl + 128 + 4 * ((r & 3) + 8 * (r >> 2))); } } while (0)
#define KBASE(t) ((j_lo + (t)) * KVBLK)
#define MASKT(P0_, P1_, t) do { const int kb_ = KBASE(t); if (kb_ + KVBLK - 1 > qlo) mask_tile(P0_, P1_, qm - kb_); } while (0)
    constexpr int NQL = 8;
#define SEAM_K0() do { VMWN(NQL); SWRITE_HK(0); NFWRITE(0); SBAR(); } while (0)
    f32x16 pA0, pA1, pB0, pB1; float mnA, mnB, alA, alB; bf16x8 pa0, pa1, pa2, pa3;
    SWRITE_HV(0); SBAR();
    if (NT > 1) { NFLOAD(cur, KBASE(1)); SLOAD_H(KSRC(cur, KBASE(1)), VSRC(cur, KBASE(1)), KBASE(1)); }
    SBAR(); if (wlive) { qkt<0, QP>(pA0, pA1, K_lds, wl, r32, hi, S.qr, qp);
    MASKT(pA0, pA1, 0); partialSM(pA0, pA1, m_reg, mnA, alA); }
    if (NT > 1) { VMW(); SWRITE_HV(1); SWRITE_HK(1); NFWRITE(1); }
    __syncthreads();
#define HALF_STEP(PX0, PX1, mnX, alX, PY0, PY1, alY, t, KB, VB, SB) do {                                                      \
        SBAR(); if (wlive) { qkt<KB, QP>(PX0, PX1, K_lds, wl, r32, hi, S.qr, qp);                                              \
        finishSM(PY0, PY1, alY, l_reg, pa0, pa1, pa2, pa3); } SBAR();                                                         \
        if ((t) + 1 < NT) { NFLOAD(cur, KBASE((t) + 1)); SLOAD_H(KSRC(cur, KBASE((t) + 1)), VSRC(cur, KBASE((t) + 1)), KBASE((t) + 1)); SBAR(); }          \
        if (wlive) { pv_tile<VB>(o, vb0, pa0, pa1, pa2, pa3); MASKT(PX0, PX1, (t)); partialSM(PX0, PX1, m_reg, mnX, alX); }    \
        __syncthreads();                                                                                                      \
        if ((t) + 1 < NT) { VMW(); SWRITE_HV(SB); SWRITE_HK(SB); NFWRITE(SB); }                                             \
        if (wlive) RESC(alX); __syncthreads(); } while (0)
    for (int t = 1; t + 1 < NT; t += 2) {
        HALF_STEP(pB0, pB1, mnB, alB, pA0, pA1, alA, t, 1, 0, 0);
        HALF_STEP(pA0, pA1, mnA, alA, pB0, pB1, alB, t + 1, 0, 1, 1);
    }
    const bool even = (NT & 1) == 0;
    if (even) { SBAR(); if (wlive) qkt<1, QP>(pB0, pB1, K_lds, wl, r32, hi, S.qr, qp); SBAR(); }
    const int qrown0 = wid * QBLK < nxt.qrows ? wid * QBLK : 0;
    const int kbn = fox_jlo<TIn>(wsb, nxt, Dskip, lane) * KVBLK;
    NFLOAD(nxt, kbn);
    SLOAD_H(KSRC(nxt, kbn), VSRC(nxt, kbn), kbn);
    SBAR();
#pragma unroll
    for (int d0 = 0; d0 < 8; ++d0) S.qr[d0] = load8<bf16>(uni(BQ(nxt) + (size_t)qrown0 * LD + d0 * 16) + lane_q);
    SBAR();
    if (wlive) { finishSM(pA0, pA1, alA, l_reg, pa0, pa1, pa2, pa3); } SBAR();
    if (wlive) pv_tile<0>(o, vb0, pa0, pa1, pa2, pa3);
    if (even) { if (wlive) { MASKT(pB0, pB1, NT - 1); partialSM(pB0, pB1, m_reg, mnB, alB); } __syncthreads(); if (wlive) { RESC(alB);
        finishSM(pB0, pB1, alB, l_reg, pa0, pa1, pa2, pa3); } SBAR(); if (wlive) pv_tile<1>(o, vb0, pa0, pa1, pa2, pa3); }
    SBAR(); SEAM_K0();
    if (hi == 0) li_l[r32] = l_reg; asm volatile("s_waitcnt lgkmcnt(0)" ::: "memory");
    float rli[16];
#pragma unroll
    for (int r = 0; r < 16; ++r) rli[r] = __builtin_amdgcn_rcpf(*(const float*)(wl + 4 * ((r & 3) + 8 * (r >> 2))));
    bf16* Ow = (bf16*)(wsw + cur.o) + (size_t)(wid * QBLK) * LD; const unsigned lane_o = (unsigned)(4 * hi * LD + r32);
    if (wlive) {
#pragma unroll
    for (int r = 0; r < 16; ++r) { bf16* Or = Ow + (size_t)((r & 3) + 8 * (r >> 2)) * LD;
#pragma unroll
        for (int d0 = 0; d0 < 4; ++d0) { const float v = o[d0][r] * rli[r]; const float vn = __shfl_xor(v, 1);
            if ((r32 & 1) == 0) *(unsigned*)(Or + d0 * 32 + lane_o) = cvtpk(v, vn); } } }
    __syncthreads();
#undef RESC
#undef KBASE
#undef MASKT
#undef SEAM_K0
#undef HALF_STEP
}
#undef ROW
#undef VMW
#undef VMWN
#undef SLOAD_H
#undef SWRITE_HK
#undef SWRITE_HV
#undef NFLOAD
#undef NFWRITE
#undef KSRC
#undef VSRC
#undef BQ
#undef BK
#undef BV
#undef BNF
#undef KSWZ
#undef SBAR
}


constexpr int DM = 4096, DFF = 11008, NPR = 8192, NSR = 2048, MR = NPR + NSR;
constexpr int SEQ = 4096, NBP = 2, NBS = 32, TS = 64, PAST = 1024, SKVS = PAST + TS;
constexpr int NH = 16, HD = 128, DA = 2048, DS = 2048, NG = 128, SG = 16, NP = 64, NIN = 8208;
constexpr float EPS = 1e-6f;
constexpr int NWAVES = 8;
constexpr int N_PHASES = 15;
#ifndef GEMM_ALIGN
#define GEMM_ALIGN true
#endif
#ifndef GEMM_SP2
#define GEMM_SP2 true
#endif
#ifndef P8_HOSTS_OB_NORM
#define P8_HOSTS_OB_NORM 1
#endif
#ifndef P4_PSHUF
#define P4_PSHUF 1
#endif
#ifndef P7_ROTATE
#define P7_ROTATE 3
#endif
#ifndef P2_HOSTS_CONVERSION
#define P2_HOSTS_CONVERSION 1
#endif
#ifndef MK_ONE_LAUNCH
#define MK_ONE_LAUNCH 1
#endif

constexpr size_t O_Y = 0, O_KP = (size_t)MR * DM, O_VP = O_KP + (size_t)NPR * DA, O_LP = O_VP + (size_t)NPR * DA, O_SRP = O_LP + (size_t)NPR * NH, O_SIP = O_SRP + NBP * NG * NP,
                 O_KS = O_SIP + NBP * NG * NP, O_VS = O_KS + (size_t)NSR * DA, O_LS = O_VS + (size_t)NSR * DA, O_SRS = O_LS + (size_t)NSR * NH, O_SIS = O_SRS + NBS * NG * NP, O_END = O_SIS + NBS * NG * NP;
static_assert(O_END == 84606976, "output size");

constexpr size_t MiB = 1u << 20;
constexpr size_t WS_CTL = 0, CTL_ZERO_BYTES = 32768;
constexpr size_t WS_W13A = 2 * MiB;
constexpr size_t WS_W2A = WS_W13A + 172 * MiB;
constexpr size_t WS_W13B = WS_W2A + 86 * MiB;
constexpr size_t WS_W2B = WS_W13B + 172 * MiB;
constexpr size_t WS_WIN = WS_W2B + 86 * MiB;
constexpr size_t WS_WF = WS_WIN + 64 * MiB;
constexpr size_t WS_WGLU = WS_WF + 1 * MiB;
constexpr size_t WS_WOUT = WS_WGLU + 8 * MiB;
constexpr size_t WS_XN = WS_WOUT + 32 * MiB;
constexpr size_t WS_H = WS_XN + 80 * MiB;
constexpr size_t WS_ZQ = WS_H;
constexpr size_t WS_ZK = WS_H + 80 * MiB;
constexpr size_t WS_QN = WS_H + 160 * MiB;
constexpr size_t WS_U = WS_H + 215 * MiB;
constexpr size_t WS_OB = WS_U + 80 * MiB;
constexpr size_t WS_YS = WS_OB + 40 * MiB;
constexpr size_t WS_YG = WS_YS + 40 * MiB;
constexpr size_t WS_KBP = WS_YG + 40 * MiB;
constexpr size_t WS_VBP = WS_KBP + 32 * MiB;
constexpr size_t WS_KBS = WS_VBP + 32 * MiB;
constexpr size_t WS_VBS = WS_KBS + 136 * MiB;
constexpr size_t WS_NFP = WS_VBS + 136 * MiB;
constexpr size_t WS_FQP = WS_NFP + 1 * MiB;
constexpr size_t WS_NFS = WS_FQP + 1 * MiB;
constexpr size_t WS_FQS = WS_NFS + 3 * MiB;
constexpr size_t WS_LAMB = WS_FQS + 1 * MiB;
constexpr size_t WS_LAM64 = WS_LAMB + 1 * MiB;
constexpr size_t WS_BB = WS_LAM64 + 1 * MiB;
constexpr size_t WS_CC = WS_BB + 1 * MiB;
constexpr size_t WS_SLOC = WS_CC + 1 * MiB;
constexpr size_t WS_XIN = WS_SLOC + 8 * MiB;
constexpr size_t WS_S2 = WS_XIN + 8 * MiB;
constexpr size_t WS_END = WS_S2 + 32 * MiB;
static_assert(WS_END <= 1900 * MiB && WS_END < 0xFFFFFFFFull, "workspace map (the attention body addresses it with 32-bit byte offsets)");
constexpr int CW_BAR = 4096;

constexpr int RING_OFF = 0, RING_BYTES = 131072;
constexpr int LDSCTL_OFF = RING_BYTES, MISC_OFF = LDSCTL_OFF + 320;
constexpr int LDS_BYTES = 147456;

#define GAS __attribute__((address_space(1)))
#define LAS __attribute__((address_space(3)))
typedef unsigned short bf16;
typedef unsigned v4u __attribute__((ext_vector_type(4)));
typedef unsigned v2u __attribute__((ext_vector_type(2)));
typedef float f32x4 __attribute__((ext_vector_type(4)));
typedef short bf16x8 __attribute__((ext_vector_type(8)));
#define LDS_WAIT() asm volatile("s_waitcnt lgkmcnt(0)" ::: "memory")
#define VM_WAIT() asm volatile("s_waitcnt vmcnt(0)" ::: "memory")
__device__ __forceinline__ unsigned pk2(float lo, float hi) { unsigned r; asm volatile("v_cvt_pk_bf16_f32 %0, %1, %2" : "=v"(r) : "v"(lo), "v"(hi)); return r; }
__device__ __forceinline__ float bf_lo(unsigned w) { return __uint_as_float(w << 16); }
__device__ __forceinline__ float bf_hi(unsigned w) { return __uint_as_float(w & 0xffff0000u); }

#define XB_TMO      128
#define XB_XCNT(j)  (256  + 64 * (j))
#define XB_XSUB(j)  (1280 + 64 * (j))
#define XB_XGEN(j)  (2304 + 64 * (j))
#define XB_TOP      3328
#define XB_TOPGEN   3392
#define XCD_BAR_WORDS 3456
#define XB_SPIN_CAP (1u << 18)

__device__ __forceinline__ unsigned xb_ld(unsigned* p)              { return __hip_atomic_load(p, __ATOMIC_RELAXED, __HIP_MEMORY_SCOPE_AGENT); }
__device__ __forceinline__ unsigned xb_add(unsigned* p, unsigned v) { return __hip_atomic_fetch_add(p, v, __ATOMIC_RELAXED, __HIP_MEMORY_SCOPE_AGENT); }
__device__ __forceinline__ unsigned xb_xcc_id() { return (unsigned)__builtin_amdgcn_s_getreg((3 << 11) | 20) & 0xFu; }
#define XB_SPIN(cond, bar) do { unsigned _sp = 0; while (cond) { __builtin_amdgcn_s_sleep(1); \
    if ((++_sp & 255u) == 0u) { if (xb_ld(&(bar)[XB_TMO])) break; if (_sp > XB_SPIN_CAP) { atomicAdd(&(bar)[XB_TMO], 1u); break; } } } } while (0)

struct XcdBarrier {
    unsigned* bar; unsigned x;
    volatile LAS unsigned* st;
};

__device__ __forceinline__ XcdBarrier xcd_barrier_post(unsigned* bar, volatile LAS unsigned* st) {
    XcdBarrier b; b.bar = bar; b.x = xb_xcc_id(); b.st = st;
    if (threadIdx.x == 0) (void)xb_add(&bar[XB_XCNT(b.x)], 1u);
    return b;
}
__device__ __forceinline__ void xcd_barrier_complete(unsigned* bar, unsigned x, unsigned& nloc, unsigned& nx) {
    const unsigned G = gridDim.x * gridDim.y * gridDim.z;
    unsigned sum, cnt, mine, sp = 0u;
    for (;;) {
        sum = 0u; cnt = 0u; mine = 0u;
#pragma unroll
        for (unsigned j = 0; j < 16; ++j) { const unsigned c = xb_ld(&bar[XB_XCNT(j)]); sum += c; cnt += (c > 0u) ? 1u : 0u; mine = (j == x) ? c : mine; }
        if (sum == G) break;
        __builtin_amdgcn_s_sleep(1);
        if ((++sp & 255u) == 0u) { if (xb_ld(&bar[XB_TMO])) break; if (sp > XB_SPIN_CAP) { atomicAdd(&bar[XB_TMO], 1u); break; } }
    }
    nloc = mine > 0u ? mine : 1u; nx = cnt > 0u ? cnt : 1u;
}

__device__ __forceinline__ void xcd_barrier(const XcdBarrier& b) {
    asm volatile("s_waitcnt vmcnt(0)" ::: "memory");
    __syncthreads();
    if (threadIdx.x == 0) {
        unsigned* bar = b.bar;
        __builtin_amdgcn_s_waitcnt(0);
        unsigned nloc = b.st[0], nx = b.st[1];
        if (nloc == 0u) { xcd_barrier_complete(bar, b.x, nloc, nx); b.st[0] = nloc; b.st[1] = nx; }
        const unsigned old = xb_add(&bar[XB_XSUB(b.x)], 1u);
        const unsigned gen = old / nloc;
        if (old + 1u == (gen + 1u) * nloc) {
            __builtin_amdgcn_fence(__ATOMIC_RELEASE, "agent");
            asm volatile("s_waitcnt vmcnt(0)" ::: "memory");
            const unsigned og = xb_add(&bar[XB_TOP], 1u);
            const unsigned tg = og / nx;
            if (og + 1u == (tg + 1u) * nx) xb_add(&bar[XB_TOPGEN], 1u);
            else XB_SPIN(xb_ld(&bar[XB_TOPGEN]) == tg, bar);
            __builtin_amdgcn_fence(__ATOMIC_ACQUIRE, "agent");
            xb_add(&bar[XB_XGEN(b.x)], 1u);
            asm volatile("s_waitcnt vmcnt(0)" ::: "memory");
        } else {
            XB_SPIN(xb_ld(&bar[XB_XGEN(b.x)]) == gen, bar);
            __builtin_amdgcn_fence(__ATOMIC_ACQUIRE, "agent");
            asm volatile("s_waitcnt vmcnt(0)" ::: "memory");
        }
    }
    __syncthreads();
}

constexpr int QKTAB_OFF = LDSCTL_OFF + 1024;
constexpr int ARGTAB_OFF = LDSCTL_OFF + 512;
__device__ __forceinline__ const float* inp_ptr(LAS unsigned char* lds, int i) {
    const LAS unsigned* t = (const LAS unsigned*)(lds + ARGTAB_OFF) + 2 * i;
    const unsigned lo = (unsigned)__builtin_amdgcn_readfirstlane((int)t[0]), hi = (unsigned)__builtin_amdgcn_readfirstlane((int)t[1]);
    return (const float*)(const GAS float*)(((unsigned long long)hi << 32) | lo);
}
struct Wv { int lane, wave, gw, ngw; };
__device__ __forceinline__ float wave_sum(float v) {
#pragma unroll
    for (int o = 1; o < 64; o <<= 1) v += __shfl_xor(v, o);
    return v;
}
__device__ __forceinline__ float fsig(float x) { return __builtin_amdgcn_rcpf(1.0f + __builtin_amdgcn_exp2f(-1.4426950408889634f * x)); }
__device__ __forceinline__ bf16x8 pack8f(f32x4 a, f32x4 b) { v4u w = {pk2(a[0], a[1]), pk2(a[2], a[3]), pk2(b[0], b[1]), pk2(b[2], b[3])}; return *reinterpret_cast<bf16x8*>(&w); }

__device__ __forceinline__ void transpose_item(const float* W, int ldw, int K, int k0, int nsrc0, bf16* WT, int drow0, LAS float* scr, int lane) {
#pragma unroll 8
    for (int i = 0; i < 32; ++i) { const int kk = 2 * i + (lane >> 5); scr[kk * 33 + (lane & 31)] = __builtin_nontemporal_load(W + (size_t)(k0 + kk) * ldw + nsrc0 + (lane & 31)); }
    LDS_WAIT(); asm volatile("" ::: "memory");
    const int c = lane & 7;
#pragma unroll
    for (int j = 0; j < 4; ++j) { const int n = (lane >> 3) + 8 * j; const LAS float* s = scr + (8 * c) * 33 + n;
        v4u o; o.x = pk2(s[0 * 33], s[1 * 33]); o.y = pk2(s[2 * 33], s[3 * 33]); o.z = pk2(s[4 * 33], s[5 * 33]); o.w = pk2(s[6 * 33], s[7 * 33]);
        *(GAS v4u*)(WT + (size_t)(drow0 + n) * K + k0 + 8 * c) = o; }
    LDS_WAIT(); asm volatile("" ::: "memory");
}
__device__ __forceinline__ void rms_row_4096(float* xrow, const float* addrow, const float* gain, bf16* orow, int lane) {
    GAS f32x4* xr = (GAS f32x4*)xrow + lane;
    f32x4 v[16]; float s = 0.f;
    if (addrow) { const GAS f32x4* ar = (const GAS f32x4*)addrow + lane;
#pragma unroll
        for (int j = 0; j < 16; ++j) { v[j] = xr[64 * j] + ar[64 * j]; xr[64 * j] = v[j]; } }
    else {
#pragma unroll
        for (int j = 0; j < 16; ++j) v[j] = xr[64 * j]; }
#pragma unroll
    for (int j = 0; j < 16; ++j) s += (v[j].x * v[j].x + v[j].y * v[j].y) + (v[j].z * v[j].z + v[j].w * v[j].w);
    const float rstd = rsqrtf(wave_sum(s) * (1.f / 4096.f) + EPS);
    const GAS f32x4* gr = (const GAS f32x4*)gain + lane;
    GAS v2u* o8 = (GAS v2u*)orow + lane;
#pragma unroll
    for (int j = 0; j < 16; ++j) { const f32x4 g = gr[64 * j]; v2u w; w.x = pk2(v[j].x * rstd * g.x, v[j].y * rstd * g.y); w.y = pk2(v[j].z * rstd * g.z, v[j].w * rstd * g.w); o8[64 * j] = w; }
}
__device__ __forceinline__ void ssm_lam(const float* lam_re, const float* lam_im, const float* log_dt, int g, int p, float& lr, float& li, float& cr, float& ci) {
    const float a = lam_re[g * NP + p], b = lam_im[g * NP + p], dt = expf(log_dt[g]);
    const float ar = a * dt, th = b * dt;
    const float er = expf(ar), sn = sinf(th), cs = cosf(th);
    lr = er * cs; li = er * sn;
    const float sh = sinf(0.5f * th), nr = expm1f(ar) * cs - 2.f * sh * sh, ni = li, den = a * a + b * b;
    cr = (nr * a + ni * b) / den; ci = (ni * a - nr * b) / den;
}
__device__ __forceinline__ float log_sigmoid(float z) { return z >= 0.f ? -log1pf(expf(-z)) : z - log1pf(expf(z)); }

constexpr int XT_PITCH = 136;
template <bool FULL>
__device__ __forceinline__ void ssm_chunk(const float* U, int row0, int g, const float* lamb, const bf16* BB, const bf16* CC, const float* dskip, bf16* YS,
                                          float& xr, float& xi, LAS float* bu_l, LAS bf16* xt_l, int lane) {
    typedef float f32x2 __attribute__((ext_vector_type(2)));
    const f32x2 lam = *(const f32x2*)(lamb + (g * NP + lane) * 2);
    const float lr = lam.x, li = lam.y;
    bf16x8 bfr[8];
#pragma unroll
    for (int nb = 0; nb < 8; ++nb) bfr[nb] = *(const bf16x8*)(BB + ((size_t)(g * 8 + nb) * 64 + lane) * 8);
    bf16x8 cfr[4];
    if constexpr (FULL) {
#pragma unroll
        for (int kk = 0; kk < 4; ++kk) cfr[kk] = *(const bf16x8*)(CC + ((size_t)(g * 4 + kk) * 64 + lane) * 8);
    }
    const int t16 = lane & 15, kq = lane >> 4;
    f32x4 ua = {0.f, 0.f, 0.f, 0.f}, ub = {0.f, 0.f, 0.f, 0.f};
    if (kq < 2) { const float* up = U + (size_t)(row0 + t16) * DS + g * SG + 8 * kq; ua = *(const f32x4*)up; ub = *(const f32x4*)(up + 4); }
#pragma unroll 1
    for (int sub = 0; sub < 4; ++sub) {
        const int row = row0 + 16 * sub + t16;
        const bf16x8 a = pack8f(ua, ub);
        if (sub < 3 && kq < 2) { const float* up = U + (size_t)(row + 16) * DS + g * SG + 8 * kq; ua = *(const f32x4*)up; ub = *(const f32x4*)(up + 4); }
        f32x4 bacc[8];
#pragma unroll
        for (int nb = 0; nb < 8; ++nb) { const f32x4 z = {0.f, 0.f, 0.f, 0.f}; bacc[nb] = __builtin_amdgcn_mfma_f32_16x16x32_bf16(a, bfr[nb], z, 0, 0, 0); }
        __builtin_amdgcn_sched_barrier(0);
#pragma unroll
        for (int nb = 0; nb < 8; ++nb)
#pragma unroll
            for (int j = 0; j < 4; ++j) bu_l[(4 * kq + j) * 128 + 16 * nb + t16] = bacc[nb][j];
        LDS_WAIT(); __builtin_amdgcn_sched_barrier(0);
        LDS_WAIT(); __builtin_amdgcn_wave_barrier(); asm volatile("" ::: "memory");
        f32x2 bv[16];
#pragma unroll
        for (int t = 0; t < 16; ++t) bv[t] = *(const LAS f32x2*)(bu_l + t * 128 + 2 * lane);
        LDS_WAIT(); __builtin_amdgcn_sched_barrier(0);
        unsigned xw[16];
#pragma unroll
        for (int t = 0; t < 16; ++t) { const float nxr = fmaf(lr, xr, fmaf(-li, xi, bv[t].x)), nxi = fmaf(lr, xi, fmaf(li, xr, bv[t].y)); xr = nxr; xi = nxi;
            if constexpr (FULL) xw[t] = pk2(xr, xi); }
        if constexpr (FULL) {
            __builtin_amdgcn_sched_barrier(0);
#pragma unroll
            for (int t = 0; t < 16; ++t) *(LAS unsigned*)(xt_l + t * XT_PITCH + 2 * lane) = xw[t]; }
        if constexpr (FULL) {
            LDS_WAIT(); __builtin_amdgcn_wave_barrier(); asm volatile("" ::: "memory");
            f32x4 y = {0.f, 0.f, 0.f, 0.f};
#pragma unroll
            for (int kk = 0; kk < 4; ++kk) { const bf16x8 xb = *(const LAS bf16x8*)(xt_l + t16 * XT_PITCH + 32 * kk + 8 * kq); y = __builtin_amdgcn_mfma_f32_16x16x32_bf16(cfr[kk], xb, y, 0, 0, 0); }
            const f32x4 u4 = *(const f32x4*)(U + (size_t)row * DS + g * SG + 4 * kq), d4 = *(const f32x4*)(dskip + g * SG + 4 * kq);
            float o[4];
#pragma unroll
            for (int j = 0; j < 4; ++j) { const float v = y[j] + d4[j] * u4[j]; o[j] = v * fsig(1.5957691216057308f * (v + 0.044715f * v * v * v)); }
            v2u w; w.x = pk2(o[0], o[1]); w.y = pk2(o[2], o[3]);
#if defined(DBG_NO_YS_STORE)
            asm volatile("" :: "v"(w.x), "v"(w.y));
#else
            *(GAS v2u*)(YS + (size_t)row * DS + g * SG + 4 * kq) = w;
#endif
        }
        LDS_WAIT(); __builtin_amdgcn_wave_barrier(); asm volatile("" ::: "memory");
    }
}


struct Args { const float* in[32]; float* out; unsigned char* ws; int ph_lo, ph_hi, sub, pad; };
enum { I_XP = 0, I_XS, I_CK, I_CV, I_CLF, I_SRE, I_SIM, I_NF1, I_W1A, I_W3A, I_W2A, I_NMIX, I_WIN, I_BF, I_QN, I_KN, I_LRE, I_LIM, I_LDT, I_BRE, I_BIM, I_CRE, I_CIM, I_DSK, I_WGLU,
       I_ONA, I_ONS, I_WOUT, I_NF2, I_W1B, I_W3B, I_W2B };

__global__ void __launch_bounds__(NWAVES * 64, 2) fwd_kernel(Args args) {
    extern __shared__ __attribute__((aligned(16))) unsigned char lds_raw[];
    LAS unsigned char* lds = (LAS unsigned char*)lds_raw;
    volatile LAS unsigned* MISC = (volatile LAS unsigned*)(lds + MISC_OFF);
    const int tid = threadIdx.x, lane = tid & 63, wave = __builtin_amdgcn_readfirstlane(tid >> 6);
    const int G = gridDim.x; const int bx = blockIdx.x; const int vcu = (G % 8 == 0) ? (bx % 8) * (G / 8) + bx / 8 : bx;
    Wv W; W.lane = lane; W.wave = wave; W.gw = vcu * NWAVES + wave; W.ngw = G * NWAVES;
    unsigned char* ws = args.ws; float* out = args.out;
    unsigned* ctl = (unsigned*)(ws + WS_CTL);
    bf16* W13A = (bf16*)(ws + WS_W13A); bf16* W2A = (bf16*)(ws + WS_W2A); bf16* W13B = (bf16*)(ws + WS_W13B); bf16* W2B = (bf16*)(ws + WS_W2B);
    bf16* WINT = (bf16*)(ws + WS_WIN); bf16* WFT = (bf16*)(ws + WS_WF); bf16* WGLUT = (bf16*)(ws + WS_WGLU); bf16* WOUTT = (bf16*)(ws + WS_WOUT);
    bf16* XN = (bf16*)(ws + WS_XN); bf16* HB = (bf16*)(ws + WS_H);
    bf16* QNB = (bf16*)(ws + WS_QN); float* UU = (float*)(ws + WS_U);
    bf16* KBP = (bf16*)(ws + WS_KBP); bf16* VBP = (bf16*)(ws + WS_VBP); bf16* KBS = (bf16*)(ws + WS_KBS); bf16* VBS = (bf16*)(ws + WS_VBS);
    bf16* OB = (bf16*)(ws + WS_OB); bf16* YS = (bf16*)(ws + WS_YS); bf16* YG = (bf16*)(ws + WS_YG);
    float* NFP = (float*)(ws + WS_NFP); float* FQP = (float*)(ws + WS_FQP); float* NFS = (float*)(ws + WS_NFS); float* FQS = (float*)(ws + WS_FQS);
    float* LAMB = (float*)(ws + WS_LAMB); float* LAM64 = (float*)(ws + WS_LAM64); bf16* BB = (bf16*)(ws + WS_BB); bf16* CC = (bf16*)(ws + WS_CC);
    float* SLOC = (float*)(ws + WS_SLOC); float* XIN = (float*)(ws + WS_XIN); float* S2 = (float*)(ws + WS_S2);
    float* Y = out + O_Y;

    for (int u = tid; u < (LDS_BYTES - LDSCTL_OFF) / 4; u += NWAVES * 64) ((LAS unsigned*)(lds + LDSCTL_OFF))[u] = 0u;
    __syncthreads();
    if (tid == 0) {
#pragma unroll
        for (int i = 0; i < 32; ++i) ((LAS unsigned long long*)(lds + ARGTAB_OFF))[i] = (unsigned long long)args.in[i]; }
    __syncthreads();
#define INP(i) inp_ptr(lds, (i))
#if MK_ONE_LAUNCH
    XcdBarrier bar = xcd_barrier_post(ctl + CW_BAR, MISC + 8);
#define GRID_BAR() xcd_barrier(bar)
#else
#define GRID_BAR() do { } while (0)
#endif
    const int lo = args.ph_lo, hi = args.ph_hi, sub = args.sub;
#ifndef PHASE_MASK
#define PHASE_MASK 0xFFFFFFFFu
#endif
#define IN(k) ((((PHASE_MASK) >> (k)) & 1u) && lo <= (k) && (k) < hi)
#define BOTH(k) (IN(k) && IN((k) + 1))

    constexpr int CV_I_FF = (DM / 64) * (DFF / 32), CV_I_IN = (DM / 64) * (8192 / 32), CV_I_GLU = (DS / 64) * (DS / 32), CV_NITEMS = 4 * CV_I_FF + CV_I_IN + CV_I_GLU;
#define CONVERT_RANGE(lo_, hi_, w0_, nw_) do { LAS float* scr_ = (LAS float*)(lds + RING_OFF + wave * 16384); \
        for (int it_ = (lo_) + (w0_); it_ < (hi_); it_ += (nw_)) { int r = it_; \
            if (r < 4 * CV_I_FF) { const int which = r / CV_I_FF; r -= which * CV_I_FF; const int kb = r / (DFF / 32), nb = r % (DFF / 32), n0 = 32 * nb; \
                const float* src = INP(which == 0 ? I_W1A : (which == 1 ? I_W3A : (which == 2 ? I_W1B : I_W3B))); \
                transpose_item(src, DFF, DM, 64 * kb, n0, which < 2 ? W13A : W13B, 256 * (n0 / 128) + 128 * (which & 1) + (n0 % 128), scr_, lane); continue; } \
            r -= 4 * CV_I_FF; \
            if (r < CV_I_IN) { const int kb = r / 256, nb = r % 256, n0 = 32 * nb; \
                transpose_item(INP(I_WIN), NIN, DM, 64 * kb, n0 < 6144 ? n0 : n0 + 16, WINT, n0, scr_, lane); continue; } \
            r -= CV_I_IN; \
            { const int kb = r / (DS / 32), nb = r % (DS / 32); transpose_item(INP(I_WGLU), DS, DS, 64 * kb, 32 * nb, WGLUT, 32 * nb, scr_, lane); } } } while (0)
#define TAIL_CONVERT(nwg_, src_, N_, K_, dst_) do { const int extra_ = (nwg_) % G; if (bx >= extra_) { const float* srcp_ = (src_);     \
        LAS float* scr_ = (LAS float*)(lds + RING_OFF + wave * 16384); const int nbk_ = (N_) / 32, nit_ = ((K_) / 64) * nbk_; \
        for (int it_ = (bx - extra_) * NWAVES + wave; it_ < nit_; it_ += (G - extra_) * NWAVES) { const int kb_ = it_ / nbk_, nb_ = it_ % nbk_; \
            transpose_item(srcp_, (N_), (K_), 64 * kb_, 32 * nb_, (dst_), 32 * nb_, scr_, lane); } } } while (0)
    if (IN(0)) {
        LAS float* scr = (LAS float*)(lds + RING_OFF + wave * 16384);
#if P2_HOSTS_CONVERSION
        CONVERT_RANGE(0, 2 * CV_I_FF, W.gw, W.ngw);
#if defined(P2CONV_ONLY_W13B)
        CONVERT_RANGE(4 * CV_I_FF, CV_NITEMS, W.gw, W.ngw);
#endif
#else
        CONVERT_RANGE(0, CV_NITEMS, W.gw, W.ngw);
#endif
        for (int kq = W.gw; kq < DM / 64; kq += W.ngw) { const int k = 64 * kq + lane; const float* s = INP(I_WIN) + (size_t)k * NIN + 6144;
#pragma unroll
            for (int n4 = 0; n4 < 4; ++n4) { const f32x4 v = *(const f32x4*)(s + 4 * n4);
#pragma unroll
                for (int j = 0; j < 4; ++j) WFT[(size_t)(4 * n4 + j) * DM + k] = (bf16)(pk2(v[j], 0.f) & 0xffffu); } }
        { const int gt = W.gw * 64 + lane, ngt = W.ngw * 64;
          const float* lre = INP(I_LRE); const float* lim = INP(I_LIM); const float* ldt = INP(I_LDT);
          for (int i = gt; i < NG * NP; i += ngt) { const int g = i / NP, p = i % NP; float lr, li, cr, ci; ssm_lam(lre, lim, ldt, g, p, lr, li, cr, ci);
              LAMB[2 * i] = lr; LAMB[2 * i + 1] = li; float pr = lr, pi = li;
#pragma unroll
              for (int s = 0; s < 6; ++s) { const float t = pr * pr - pi * pi; pi = 2.f * pr * pi; pr = t; }
              LAM64[2 * i] = pr; LAM64[2 * i + 1] = pi; }
          const float* bre = INP(I_BRE); const float* bim = INP(I_BIM);
          for (int i = gt; i < NG * 8 * 64; i += ngt) { const int g = i / 512, nb = (i / 64) % 8, l = i % 64, kq = l >> 4; v4u w = {0u, 0u, 0u, 0u};
              if (kq < 2) { const int n = 16 * nb + (l & 15), p = n >> 1, ri = n & 1; float lr, li, cr, ci; ssm_lam(lre, lim, ldt, g, p, lr, li, cr, ci);
                  const float* br = bre + ((size_t)(g * NP + p)) * SG + 8 * kq; const float* bi = bim + ((size_t)(g * NP + p)) * SG + 8 * kq; float v[8];
#pragma unroll
                  for (int j = 0; j < 8; ++j) v[j] = ri == 0 ? cr * br[j] - ci * bi[j] : cr * bi[j] + ci * br[j];
                  w.x = pk2(v[0], v[1]); w.y = pk2(v[2], v[3]); w.z = pk2(v[4], v[5]); w.w = pk2(v[6], v[7]); }
              *(v4u*)(BB + (size_t)i * 8) = w; }
          const float* cre = INP(I_CRE); const float* cim = INP(I_CIM);
          for (int i = gt; i < NG * 4 * 64; i += ngt) { const int g = i / 256, kk = (i / 64) % 4, l = i % 64, c = l & 15; float v[8];
#pragma unroll
              for (int j = 0; j < 8; ++j) { const int k = 32 * kk + 8 * (l >> 4) + j, p = k >> 1; v[j] = (k & 1) == 0 ? cre[((size_t)(g * SG + c)) * NP + p] : -cim[((size_t)(g * SG + c)) * NP + p]; }
              v4u w; w.x = pk2(v[0], v[1]); w.y = pk2(v[2], v[3]); w.z = pk2(v[4], v[5]); w.w = pk2(v[6], v[7]);
              *(v4u*)(CC + (size_t)i * 8) = w; } }
        for (int u = W.gw; u < NBS * NH; u += W.ngw) { const int b = u / NH, h = u % NH; const float* src = INP(I_CLF) + ((size_t)b * PAST + 16 * lane) * NH + h; float v[16]; float sm = 0.f;
#pragma unroll
            for (int i = 0; i < 16; ++i) { sm += src[(size_t)i * NH]; v[i] = sm; }
            float incl = sm;
#pragma unroll
            for (int o = 1; o < 64; o <<= 1) { const float t = __shfl_up(incl, o); if (lane >= o) incl += t; }
            const float off = incl - sm; float* nf = NFS + (size_t)u * SKVS + 16 * lane;
#pragma unroll
            for (int i = 0; i < 16; i += 4) *(f32x4*)(nf + i) = (f32x4){v[i] + off, v[i + 1] + off, v[i + 2] + off, v[i + 3] + off} * (-11.313708498984761f);
            if (lane == 63) FQS[(size_t)u * TS] = incl; }
        for (int m = W.gw; m < MR; m += W.ngw) rms_row_4096((float*)(m < NPR ? INP(I_XP) + (size_t)m * DM : INP(I_XS) + (size_t)(m - NPR) * DM), nullptr, INP(I_NF1), XN + (size_t)m * DM, lane);
        if (BOTH(0)) GRID_BAR();
    }
    if (IN(1)) {
        pg8::Gemm g{XN, W13A, MR, 2 * DFF, DM}; pg8::StaticOrder S; S.init(MR, 2 * DFF, DM, G, bx);
        pg8::EpiSwiGLU E{HB, DFF};
        pg8::gemm_phase<pg8::EpiSwiGLU, pg8::StaticOrder, GEMM_ALIGN, GEMM_SP2>(lds + RING_OFF, g, S, E);
        TAIL_CONVERT(S.nwg, INP(I_W2A), DM, DFF, W2A);
        if (BOTH(1)) GRID_BAR();
    }
    if (IN(2)) {
#if P2_HOSTS_CONVERSION
        pg8::Gemm g{HB, W2A, MR, DM, DFF}; pg8::StaticOrder S; S.init(MR, DM, DFF, G, bx);
        pg8::EpiRes E{INP(I_XP), INP(I_XS) - (size_t)NPR * DM, NPR / 256, Y, DM, 0.5f, S2 - (size_t)NPR * DM};
        pg8::gemm_phase<pg8::EpiRes, pg8::StaticOrder, GEMM_ALIGN, GEMM_SP2>(lds + RING_OFF, g, S, E);
        { const int extra = S.nwg % G;
#if defined(P2CONV_ONLY_W13B)
          if (bx >= extra) CONVERT_RANGE(2 * CV_I_FF, 4 * CV_I_FF, (bx - extra) * NWAVES + wave, (G - extra) * NWAVES); }
#else
          if (bx >= extra) CONVERT_RANGE(2 * CV_I_FF, CV_NITEMS, (bx - extra) * NWAVES + wave, (G - extra) * NWAVES); }
#endif
#else
        pg8::Gemm g{HB, W2A, MR, DM, DFF}; pg8::SplitOrder S; S.init(MR, NPR, DM, DFF, G, bx);
        pg8::EpiRes E{INP(I_XP), INP(I_XS) - (size_t)NPR * DM, NPR / 256, Y, DM, 0.5f, S2 - (size_t)NPR * DM};
        pg8::gemm_phase<pg8::EpiRes, pg8::SplitOrder, GEMM_ALIGN, GEMM_SP2>(lds + RING_OFF, g, S, E);
#endif
        if (BOTH(2)) GRID_BAR();
    }
    if (IN(3)) {
        for (int m = W.gw; m < MR; m += W.ngw) rms_row_4096(Y + (size_t)m * DM, (!P2_HOSTS_CONVERSION && m >= NPR) ? S2 + (size_t)(m - NPR) * DM : nullptr, INP(I_NMIX), XN + (size_t)m * DM, lane);
        if (BOTH(3)) GRID_BAR();
    }
    if (IN(4)) {
        pg8::Gemm g{XN, WINT, MR, 8192, DM}; pg8::StaticOrder S; S.init(MR, 8192, DM, G, bx); S.pshuf = P4_PSHUF;
        pg8::EpiWin E{QNB, out + O_KP, out + O_VP, UU, KBP, VBP, INP(I_QN), INP(I_KN), (LAS float*)(lds + QKTAB_OFF), NPR / 256,
                       (long)O_KS - (long)O_KP - (long)NPR * DA, (long)O_VS - (long)O_VP - (long)NPR * DA};
#if defined(PROBE_NULL_EPI)
        if (sub == 1) { pg8::EpiNull EN; pg8::gemm_phase<pg8::EpiNull, pg8::StaticOrder, GEMM_ALIGN, GEMM_SP2>(lds + RING_OFF, g, S, EN); } else
        if (sub == 2) { pg8::EpiNull EN; pg8::SameOrder SS{10}; pg8::gemm_phase<pg8::EpiNull, pg8::SameOrder, GEMM_ALIGN, GEMM_SP2>(lds + RING_OFF, g, SS, EN); } else
#endif
        pg8::gemm_phase<pg8::EpiWin, pg8::StaticOrder, GEMM_ALIGN, GEMM_SP2>(lds + RING_OFF, g, S, E);
        if (BOTH(4)) GRID_BAR();
    }
    if (IN(5)) {
        if (sub & 1) { const float* bfv = INP(I_BF);
          LAS f32x4* red = (LAS f32x4*)(lds + RING_OFF);
          const int hw = wave >> 2, kq4 = wave & 3;
          for (int t0 = 2 * vcu; t0 < MR / 16; t0 += 2 * G) { const int task = t0 + hw, row0 = 16 * task; f32x4 acc = {0.f, 0.f, 0.f, 0.f};
              const bf16* ap = XN + (size_t)(row0 + (lane & 15)) * DM + 1024 * kq4 + 8 * (lane >> 4); const bf16* bp = WFT + (size_t)(lane & 15) * DM + 1024 * kq4 + 8 * (lane >> 4);
#pragma unroll 8
              for (int kk = 0; kk < 32; ++kk) acc = __builtin_amdgcn_mfma_f32_16x16x32_bf16(*(const bf16x8*)(ap + 32 * kk), *(const bf16x8*)(bp + 32 * kk), acc, 0, 0, 0);
              __builtin_amdgcn_sched_barrier(0);
              red[(hw * 4 + kq4) * 64 + lane] = acc;
              LDS_WAIT(); __builtin_amdgcn_sched_barrier(0);
              __syncthreads();
              if (kq4 == 0) { const f32x4 s4 = (red[(hw * 4 + 0) * 64 + lane] + red[(hw * 4 + 1) * 64 + lane]) + (red[(hw * 4 + 2) * 64 + lane] + red[(hw * 4 + 3) * 64 + lane]);
                  const int h = lane & 15; const float bias = bfv[h];
                  f32x4 lf4;
#pragma unroll
                  for (int j = 0; j < 4; ++j) { const int r = row0 + 4 * (lane >> 4) + j; const float lf = log_sigmoid(s4[j] + bias); lf4[j] = lf;
                      if (r < NPR) out[O_LP + (size_t)r * NH + h] = lf; else out[O_LS + (size_t)(r - NPR) * NH + h] = lf; }
                  { const int r0 = row0 + 4 * (lane >> 4); if (r0 < NPR) *(f32x4*)(FQP + ((size_t)((r0 >> 12) * NH + h)) * SEQ + (r0 & (SEQ - 1))) = lf4; } }
              __syncthreads(); } }
        if (sub & 4) { LAS float* bu_l = (LAS float*)(lds + RING_OFF + wave * 12800); LAS bf16* xt_l = (LAS bf16*)(lds + RING_OFF + wave * 12800 + 8192);
          for (int task = W.gw; task < 128 * NG; task += W.ngw) { const int sc = task / NG, g = task % NG; float xr = 0.f, xi = 0.f;
#if KVB_IN_P5
              static_assert(128 * NG == 2 * NPR, "one K or V row per scan task");
              const int cr = task >> 1; const float* csrc = out + ((task & 1) ? O_VP : O_KP) + (size_t)cr * DA; bf16* cdst = ((task & 1) ? VBP : KBP) + (size_t)cr * DA;
              f32x4 cv[8];
#pragma unroll
              for (int j = 0; j < 8; ++j) cv[j] = *(const GAS f32x4*)(csrc + 4 * (lane + 64 * j));
#endif
              ssm_chunk<false>(UU, (sc / 64) * SEQ + (sc % 64) * 64, g, LAMB, BB, CC, INP(I_DSK), YS, xr, xi, bu_l, xt_l, lane);
              SLOC[((size_t)task * NP + lane) * 2] = xr; SLOC[((size_t)task * NP + lane) * 2 + 1] = xi;
#if KVB_IN_P5
#pragma unroll
              for (int j = 0; j < 8; ++j) { v2u w; w.x = pk2(cv[j].x, cv[j].y); w.y = pk2(cv[j].z, cv[j].w); *(GAS v2u*)(cdst + 4 * (lane + 64 * j)) = w; }
#endif
          } }
        if (BOTH(5)) GRID_BAR();
    }
    if (IN(6)) {
        constexpr float RS = 11.313708498984761f;
        for (int task = W.gw; task < NBP * NH + NBS * NH; task += W.ngw) {
            if (task < NBP * NH) {
                const float* src = FQP + (size_t)task * SEQ + lane; float* nf = NFP + (size_t)task * SEQ + lane; float v[64];
#pragma unroll
                for (int c = 0; c < 64; ++c) v[c] = src[64 * c];
                float carry = 0.f;
#pragma unroll
                for (int c = 0; c < 64; ++c) { float incl = v[c];
#pragma unroll
                    for (int o = 1; o < 64; o <<= 1) { const float t = __shfl_up(incl, o); if (lane >= o) incl += t; }
                    nf[64 * c] = (carry + incl) * (-RS); carry += __shfl(incl, 63); } }
            else { const int u = task - NBP * NH, b = u / NH, h = u % NH;
                float incl = out[O_LS + ((size_t)b * TS + lane) * NH + h];
#pragma unroll
                for (int o = 1; o < 64; o <<= 1) { const float t = __shfl_up(incl, o); if (lane >= o) incl += t; }
                NFS[(size_t)u * SKVS + PAST + lane] = (FQS[(size_t)u * TS] + incl) * (-RS); }
        }
        for (int task = W.gw; task < NBP * NG; task += W.ngw) { const int b = task / NG, g = task % NG; typedef float f32x2 __attribute__((ext_vector_type(2)));
            const f32x2 l64 = *(const f32x2*)(LAM64 + (g * NP + lane) * 2); float xr = 0.f, xi = 0.f;
#pragma unroll 8
            for (int c = 0; c < 64; ++c) { const size_t idx = (((size_t)(b * 64 + c) * NG + g) * NP + lane) * 2; *(f32x2*)(XIN + idx) = (f32x2){xr, xi}; const f32x2 s = *(const f32x2*)(SLOC + idx);
                const float nxr = fmaf(l64.x, xr, fmaf(-l64.y, xi, s.x)), nxi = fmaf(l64.x, xi, fmaf(l64.y, xr, s.y)); xr = nxr; xi = nxi; }
            out[O_SRP + (size_t)task * NP + lane] = xr; out[O_SIP + (size_t)task * NP + lane] = xi; }
        if (BOTH(6)) GRID_BAR();
    }
    if (IN(7)) {
        {
          float Dskip; { const float* gqp = INP(I_QN); const float* gkp = INP(I_KN); float mq = fmaxf(fabsf(gqp[lane]), fabsf(gqp[lane + 64])), mk = fmaxf(fabsf(gkp[lane]), fabsf(gkp[lane + 64]));
#pragma unroll
              for (int o = 1; o < 64; o <<= 1) { mq = fmaxf(mq, __shfl_xor(mq, o)); mk = fmaxf(mk, __shfl_xor(mk, o)); }
              Dskip = 256.0f * mq * mk + 110.0f * 11.313708498984761f; }
#if defined(ATTN_NO_SKIP)
          Dskip = 3.0e38f;
#endif
          auto sec_prompt = [&]() __attribute__((always_inline)) {
          if (sub & 1) { typedef att::BlockRef<att::bf16> BR; att::Seam<att::bf16> S; const att::KVBase kvb{(const char*)ws, (const char*)ws, (const char*)ws};
#define MKREF(r, L_, pass_) do { const int L__ = (L_); const int bh = L__ >> 3, x = L__ & 7, qb = (pass_) ? 15 - x : x, b = bh >> 4, h = bh & 15; const unsigned r0 = (unsigned)b * SEQ, rq = r0 + (unsigned)qb * 256; \
              (r).q = (unsigned)WS_QN + (rq * DA + h * HD) * 2u; (r).k = (unsigned)WS_KBP + (r0 * DA + h * HD) * 2u; (r).v = (unsigned)WS_VBP + (r0 * DA + h * HD) * 2u; (r).k2 = (r).k; (r).v2 = (r).v; \
              (r).nf = (unsigned)WS_NFP + (unsigned)bh * SEQ * 4u; (r).o = (unsigned)WS_OB + (rq * DA + h * HD) * 2u; (r).P0 = qb * 256; (r).skv = SEQ; (r).qrows = 256; (r).split = 1 << 30; } while (0)
            int L = bx;
            if (L < 256) { int pass = 0; BR cur; MKREF(cur, L, 0);
                att::fox_prime<att::bf16>((const char*)ws, kvb, cur, Dskip, (char*)lds_raw + RING_OFF, S);
                for (;;) { const bool more_pass = pass == 0, more_item = L + G < 256, last = !more_pass && !more_item;
                    int passn = pass + 1, Ln = L; if (!more_pass) { passn = 0; Ln = more_item ? L + G : L; }
                    BR nxt = cur; if (!last) MKREF(nxt, Ln, passn);
                    att::fox_block<att::bf16>((const char*)ws, (char*)ws, kvb, cur, nxt, Dskip, (char*)lds_raw + RING_OFF, S);
                    if (last) break;
                    cur = nxt; pass = passn; L = Ln; } }
#undef MKREF
          }
          __syncthreads(); };
          auto sec_sample = [&]() __attribute__((always_inline)) {
          if (sub & 4) { typedef att::BlockRef<float> BR; att::Seam<float> S; const att::KVBase kvb{(const char*)INP(I_CK), (const char*)INP(I_CV), (const char*)out};
#define MKREF(r, U_) do { const int u = (U_), b = u >> 4, h = u & 15; const unsigned rq = (unsigned)NPR + (unsigned)b * TS; \
              (r).q = (unsigned)WS_QN + (rq * DA + h * HD) * 2u; (r).k = ((unsigned)b * PAST * DA + h * HD) * 4u; (r).v = (r).k; \
              (r).k2 = (unsigned)((O_KS + ((size_t)b * TS) * DA + h * HD - (size_t)PAST * DA) * 4); (r).v2 = (unsigned)((O_VS + ((size_t)b * TS) * DA + h * HD - (size_t)PAST * DA) * 4); \
              (r).nf = (unsigned)WS_NFS + (unsigned)u * SKVS * 4u; (r).o = (unsigned)WS_OB + (rq * DA + h * HD) * 2u; (r).P0 = PAST; (r).skv = SKVS; (r).qrows = TS; (r).split = PAST; } while (0)
            int U = bx;
            if (U < NBS * NH) { BR cur; MKREF(cur, U);
                att::fox_prime<float>((const char*)ws, kvb, cur, Dskip, (char*)lds_raw + RING_OFF, S);
                for (;;) { const bool last = U + G >= NBS * NH;
                    BR nxt = cur; if (!last) MKREF(nxt, U + G);
                    att::fox_block<float>((const char*)ws, (char*)ws, kvb, cur, nxt, Dskip, (char*)lds_raw + RING_OFF, S);
                    if (last) break;
                    cur = nxt; U += G; } }
#undef MKREF
          }
          __syncthreads(); };
          auto sec_ssm = [&]() __attribute__((always_inline)) {
        if (sub & 2) { LAS float* bu_l = (LAS float*)(lds + RING_OFF + wave * 12800); LAS bf16* xt_l = (LAS bf16*)(lds + RING_OFF + wave * 12800 + 8192);
          for (int task = W.gw; task < (128 + NBS) * NG; task += W.ngw) { const int sc = task / NG, g = task % NG; float xr, xi; int row0;
              if (sc < 128) { row0 = (sc / 64) * SEQ + (sc % 64) * 64; xr = XIN[((size_t)task * NP + lane) * 2]; xi = XIN[((size_t)task * NP + lane) * 2 + 1]; }
              else { const int b = sc - 128; row0 = NPR + b * TS; xr = INP(I_SRE)[((size_t)b * NG + g) * NP + lane]; xi = INP(I_SIM)[((size_t)b * NG + g) * NP + lane]; }
#if defined(DBG_SSM_NOFULL)
              ssm_chunk<false>(UU, row0, g, LAMB, BB, CC, INP(I_DSK), YS, xr, xi, bu_l, xt_l, lane);
#else
              ssm_chunk<true>(UU, row0, g, LAMB, BB, CC, INP(I_DSK), YS, xr, xi, bu_l, xt_l, lane);
#endif
#if defined(DBG_NO_STATE_STORE)
              asm volatile("" :: "v"(xr), "v"(xi));
#else
              if (sc >= 128) { const int b = sc - 128; out[O_SRS + ((size_t)b * NG + g) * NP + lane] = xr; out[O_SIS + ((size_t)b * NG + g) * NP + lane] = xi; }
#endif
          } }
          __syncthreads(); };
#if P7_ROTATE == 3
          const int rot = bx % 3;
          if (rot == 2) sec_ssm();
          if (rot != 1) sec_prompt();
          sec_sample();
          if (rot != 2) sec_ssm();
          if (rot == 1) sec_prompt();
#elif P7_ROTATE == 2
          const int rot = bx & 1;
          if (rot == 0) sec_sample();
          sec_prompt(); sec_ssm();
          if (rot == 1) sec_sample();
#else
          sec_prompt(); sec_sample(); sec_ssm();
#endif
        }
        if (BOTH(7)) GRID_BAR();
    }
    auto merge_half = [&](int row, int half) __attribute__((always_inline)) {
            const bf16* src = (half ? YG : OB) + (size_t)row * DA; const float* gain = INP(half ? I_ONS : I_ONA); bf16* dst = XN + (size_t)row * DM + half * DA;
            v4u v[4]; float s = 0.f;
#pragma unroll
            for (int j = 0; j < 4; ++j) { v[j] = *(const v4u*)(src + 8 * (lane + 64 * j));
                const float a0 = bf_lo(v[j].x), a1 = bf_hi(v[j].x), a2 = bf_lo(v[j].y), a3 = bf_hi(v[j].y), a4 = bf_lo(v[j].z), a5 = bf_hi(v[j].z), a6 = bf_lo(v[j].w), a7 = bf_hi(v[j].w);
                s += ((a0 * a0 + a1 * a1) + (a2 * a2 + a3 * a3)) + ((a4 * a4 + a5 * a5) + (a6 * a6 + a7 * a7)); }
            const float r = rsqrtf(wave_sum(s) * (1.f / 2048.f) + EPS);
#pragma unroll
            for (int j = 0; j < 4; ++j) { const f32x4 g0 = *(const f32x4*)(gain + 8 * (lane + 64 * j)), g1 = *(const f32x4*)(gain + 8 * (lane + 64 * j) + 4); v4u w;
                w.x = pk2(bf_lo(v[j].x) * r * g0.x, bf_hi(v[j].x) * r * g0.y); w.y = pk2(bf_lo(v[j].y) * r * g0.z, bf_hi(v[j].y) * r * g0.w);
                w.z = pk2(bf_lo(v[j].z) * r * g1.x, bf_hi(v[j].z) * r * g1.y); w.w = pk2(bf_lo(v[j].w) * r * g1.z, bf_hi(v[j].w) * r * g1.w);
                *(v4u*)(dst + 8 * (lane + 64 * j)) = w; } };
    if (IN(8)) {
        pg8::Gemm g{YS, WGLUT, MR, DS, DS}; pg8::StaticOrder S; S.init(MR, DS, DS, G, bx);
        pg8::EpiGLU E{YS, YG, DS};
        pg8::gemm_phase<pg8::EpiGLU, pg8::StaticOrder, GEMM_ALIGN, GEMM_SP2>(lds + RING_OFF, g, S, E);
        TAIL_CONVERT(S.nwg, INP(I_WOUT), DM, DM, WOUTT);
#if P8_HOSTS_OB_NORM
        { const int extra = S.nwg % G; if (bx >= extra) for (int row = (bx - extra) * NWAVES + wave; row < MR; row += (G - extra) * NWAVES) merge_half(row, 0); }
#endif
        if (BOTH(8)) GRID_BAR();
    }
    if (IN(9)) {
#if P8_HOSTS_OB_NORM
        for (int row = W.gw; row < MR; row += W.ngw) merge_half(row, 1);
#else
        for (int task = W.gw; task < 2 * MR; task += W.ngw) merge_half(task >> 1, task & 1);
#endif
        if (BOTH(9)) GRID_BAR();
    }
    if (IN(10)) {
        pg8::Gemm g{XN, WOUTT, MR, DM, DM}; pg8::SplitOrder S; S.init(MR, NPR, DM, DM, G, bx);
        pg8::EpiRes E{Y, Y, 1 << 30, Y, DM, 1.0f, S2 - (size_t)NPR * DM};
        pg8::gemm_phase<pg8::EpiRes, pg8::SplitOrder, GEMM_ALIGN, GEMM_SP2>(lds + RING_OFF, g, S, E);
        if (BOTH(10)) GRID_BAR();
    }
    if (IN(11)) {
        for (int m = W.gw; m < MR; m += W.ngw) rms_row_4096(Y + (size_t)m * DM, m >= NPR ? S2 + (size_t)(m - NPR) * DM : nullptr, INP(I_NF2), XN + (size_t)m * DM, lane);
        if (BOTH(11)) GRID_BAR();
    }
    if (IN(12)) {
        pg8::Gemm g{XN, W13B, MR, 2 * DFF, DM}; pg8::StaticOrder S; S.init(MR, 2 * DFF, DM, G, bx);
        pg8::EpiSwiGLU E{HB, DFF};
        pg8::gemm_phase<pg8::EpiSwiGLU, pg8::StaticOrder, GEMM_ALIGN, GEMM_SP2>(lds + RING_OFF, g, S, E);
        TAIL_CONVERT(S.nwg, INP(I_W2B), DM, DFF, W2B);
        if (BOTH(12)) GRID_BAR();
    }
    if (IN(13)) {
        pg8::Gemm g{HB, W2B, MR, DM, DFF}; pg8::SplitOrder S; S.init(MR, NPR, DM, DFF, G, bx);
        pg8::EpiRes E{Y, Y, 1 << 30, Y, DM, 0.5f, S2 - (size_t)NPR * DM};
        pg8::gemm_phase<pg8::EpiRes, pg8::SplitOrder, GEMM_ALIGN, GEMM_SP2>(lds + RING_OFF, g, S, E);
        if (BOTH(13)) GRID_BAR();
    }
    if (IN(14)) {
        for (size_t i = (size_t)W.gw * 64 + lane; i < (size_t)NSR * DM / 4; i += (size_t)W.ngw * 64) { GAS f32x4* yp = (GAS f32x4*)(Y + (size_t)NPR * DM) + i; *yp = *yp + ((const GAS f32x4*)S2)[i]; }
    }
#undef IN
#undef BOTH
}

#if defined(DBG_STOP_AFTER)
__global__ void dbg_fill(float* out) { for (size_t i = (size_t)blockIdx.x * blockDim.x + threadIdx.x; i < O_END / 4; i += (size_t)gridDim.x * blockDim.x) ((f32x4*)out)[i] = (f32x4){0.f, 0.f, 0.f, 0.f}; }
#endif
extern "C" void kernel_launch(void* const* d_in, const int* in_sizes, int n_in, void* d_out, int out_size, void* d_ws, size_t ws_size, hipStream_t stream) {
    static int grid = 0;
    if (grid == 0) {
        if (n_in != 32 || out_size != (int)O_END || ws_size < WS_END) { fprintf(stderr, "kernel_launch: unexpected problem (n_in %d, out %d, ws %zu; want 32, %zu, >= %zu); nothing launched\n", n_in, out_size, ws_size, (size_t)O_END, (size_t)WS_END); grid = -1; return; }
        int dev = 0, cus = 0, per_cu = 0;
        if (hipGetDevice(&dev) != hipSuccess || hipDeviceGetAttribute(&cus, hipDeviceAttributeMultiprocessorCount, dev) != hipSuccess) { fprintf(stderr, "kernel_launch: device query failed\n"); grid = -1; return; }
        if (hipFuncSetAttribute((const void*)fwd_kernel, hipFuncAttributeMaxDynamicSharedMemorySize, LDS_BYTES) != hipSuccess) { fprintf(stderr, "kernel_launch: hipFuncSetAttribute failed\n"); grid = -1; return; }
        if (hipOccupancyMaxActiveBlocksPerMultiprocessor(&per_cu, (const void*)fwd_kernel, NWAVES * 64, LDS_BYTES) != hipSuccess || per_cu < 1) { fprintf(stderr, "kernel_launch: occupancy query says %d blocks per CU\n", per_cu); }
        (void)hipGetLastError();
        grid = cus;
    }
    if (grid < 0) return;
    (void)hipMemsetAsync((char*)d_ws + WS_CTL, 0, CTL_ZERO_BYTES, stream);
    Args a{};
    for (int i = 0; i < 32; ++i) a.in[i] = (const float*)d_in[i];
    a.out = (float*)d_out; a.ws = (unsigned char*)d_ws; a.sub = 7;
#if MK_ONE_LAUNCH
    a.ph_lo = 0; a.ph_hi = N_PHASES;
    hipLaunchKernelGGL(fwd_kernel, dim3(grid), dim3(NWAVES * 64), LDS_BYTES, stream, a);
#else
#if defined(DBG_STOP_AFTER)
    hipLaunchKernelGGL(dbg_fill, dim3(1024), dim3(256), 0, stream, (float*)d_out);
#define DBG_LAST (DBG_STOP_AFTER)
#else
#define DBG_LAST (N_PHASES - 1)
#endif
#ifndef REP_MASK
#define REP_MASK 0u
#endif
#ifndef REP_SUB
#define REP_SUB 7
#endif
    for (int p = 0; p <= DBG_LAST; ++p) { a.ph_lo = p; a.ph_hi = p + 1;
        for (int r = 0; r < 1 + (int)(((unsigned)(REP_MASK) >> p) & 1u); ++r) { a.sub = r == 0 ? 7 : REP_SUB; hipLaunchKernelGGL(fwd_kernel, dim3(grid), dim3(NWAVES * 64), LDS_BYTES, stream, a); } }
#endif
    const hipError_t le = hipPeekAtLastError();
    if (le != hipSuccess) fprintf(stderr, "kernel_launch: launch failed: %s\n", hipGetErrorName(le));
}
```
